# Optimizing an MI355X kernel written in HIP

```python
import jax, jax.numpy as jnp
from jax import lax
import numpy as np

D_MODEL = 2048
BATCH = 4
SEQ = 2048
DEPTH = 4

N_A_LAYERS = DEPTH // 2
N_B_LAYERS = DEPTH - N_A_LAYERS
A_HEADS = 8
A_DV = D_MODEL // A_HEADS
A_DQK = A_DV // 2
A_CHUNK = 64
GATE_SOFTCAP = 15.0
A_IN_COLS = 2 * A_HEADS * A_DQK + 2 * A_HEADS * A_DV + 2 * A_HEADS
B_HEADS = 16
B_DH = D_MODEL // B_HEADS
B_QBLOCK = 128
D_FF = 5632
EPS = 1e-6

kernel_name = "mlstm_stickbreak_yoco_macaron"


def rms_norm(x, g):
    xf = x.astype(jnp.float32)
    y = xf * lax.rsqrt(jnp.mean(xf * xf, axis=-1, keepdims=True) + EPS)
    return (y * g.astype(jnp.float32)).astype(x.dtype)


def swiglu(x, w_in, w_out):
    gate, up = jnp.split(x @ w_in, 2, axis=-1)
    return (jax.nn.silu(gate) * up) @ w_out


def mlstm_mix(h, w_in, b_gate, head_norm, w_out):
    B, S, _ = h.shape
    H, L = A_HEADS, A_CHUNK
    NC = S // L
    proj = h @ w_in
    o1 = H * A_DQK
    o2 = 2 * H * A_DQK
    o3 = o2 + H * A_DV
    o4 = o3 + H * A_DV
    q, k, v, og, gates = proj[..., :o1], proj[..., o1:o2], proj[..., o2:o3], proj[..., o3:o4], proj[..., o4:]
    gates = gates.astype(jnp.float32) + b_gate.astype(jnp.float32)
    ig = GATE_SOFTCAP * jnp.tanh(gates[..., :H] / GATE_SOFTCAP)
    logf = jax.nn.log_sigmoid(gates[..., H:])

    def to_chunks(t, d):
        t = t.astype(jnp.float32).reshape(B, NC, L, H, d)
        return t.transpose(1, 0, 3, 2, 4)

    qc = to_chunks(q, A_DQK) * (A_DQK ** -0.5)
    kc = to_chunks(k, A_DQK)
    vc = to_chunks(v, A_DV)
    igc = ig.reshape(B, NC, L, H).transpose(1, 0, 3, 2)
    lfc = logf.reshape(B, NC, L, H).transpose(1, 0, 3, 2)
    tril = jnp.tril(jnp.ones((L, L), dtype=bool))

    def chunk_step(carry, inp):
        C, n, m = carry
        qq, kk, vv, ii, lf = inp
        b = jnp.cumsum(lf, axis=-1)
        Dm = jnp.where(tril, b[..., :, None] - b[..., None, :] + ii[..., None, :], -jnp.inf)
        m_inter = b + m[..., None]
        m_t = jnp.maximum(jnp.max(Dm, axis=-1), m_inter)
        Sw = jnp.einsum('bhtd,bhsd->bhts', qq, kk) * jnp.exp(Dm - m_t[..., None])
        dec = jnp.exp(m_inter - m_t)
        num = jnp.einsum('bhts,bhsv->bhtv', Sw, vv) + dec[..., None] * jnp.einsum('bhvd,bhtd->bhtv', C, qq)
        den = jnp.sum(Sw, axis=-1) + dec * jnp.einsum('bhd,bhtd->bht', n, qq)
        out = num / jnp.maximum(jnp.abs(den), jnp.exp(-m_t))[..., None]
        bL = b[..., -1]
        g = bL[..., None] - b + ii
        m_new = jnp.maximum(bL + m, jnp.max(g, axis=-1))
        w = jnp.exp(g - m_new[..., None])
        cdec = jnp.exp(bL + m - m_new)
        C = cdec[..., None, None] * C + jnp.einsum('bhs,bhsv,bhsd->bhvd', w, vv, kk)
        n = cdec[..., None] * n + jnp.einsum('bhs,bhsd->bhd', w, kk)
        return (C, n, m_new), out

    init = (jnp.zeros((B, H, A_DV, A_DQK), jnp.float32),
            jnp.zeros((B, H, A_DQK), jnp.float32),
            jnp.zeros((B, H), jnp.float32))
    _, hs = lax.scan(chunk_step, init, (qc, kc, vc, igc, lfc))
    hs = hs.transpose(1, 0, 3, 2, 4).reshape(B, S, H, A_DV)
    hs = hs * lax.rsqrt(jnp.mean(hs * hs, axis=-1, keepdims=True) + EPS)
    hs = hs.reshape(B, S, H * A_DV) * head_norm.astype(jnp.float32)
    hs = hs * jax.nn.sigmoid(og.astype(jnp.float32))
    return hs.astype(h.dtype) @ w_out


def shared_kv(x, g, w_kv):
    B, S, _ = x.shape
    k, v = jnp.split(rms_norm(x, g) @ w_kv, 2, axis=-1)
    k = k.astype(jnp.float32).reshape(B, S, B_HEADS, B_DH).transpose(0, 2, 1, 3)
    v = v.astype(jnp.float32).reshape(B, S, B_HEADS, B_DH).transpose(0, 2, 1, 3)
    return k, v


def stick_breaking_mix(h, w_q, k, v, w_out):
    B, S, _ = h.shape
    q = (h @ w_q).astype(jnp.float32).reshape(B, S, B_HEADS, B_DH).transpose(0, 2, 1, 3) * (B_DH ** -0.5)
    outs = []
    for blk in range(S // B_QBLOCK):
        end = (blk + 1) * B_QBLOCK
        qb = q[:, :, end - B_QBLOCK:end]
        kb = k[:, :, :end]
        vb = v[:, :, :end]
        z = jnp.einsum('bhqd,bhkd->bhqk', qb, kb)
        qpos = jnp.arange(end - B_QBLOCK, end)
        kpos = jnp.arange(end)
        mask = kpos[None, :] < qpos[:, None]
        log_not = jnp.where(mask, jax.nn.log_sigmoid(-z), 0.0)
        after = lax.cumsum(log_not, axis=3, reverse=True) - log_not
        att = jnp.where(mask, jnp.exp(jax.nn.log_sigmoid(z) + after), 0.0)
        outs.append(jnp.einsum('bhqk,bhkd->bhqd', att, vb))
    o = jnp.concatenate(outs, axis=2).transpose(0, 2, 1, 3).reshape(B, S, B_HEADS * B_DH)
    return o.astype(h.dtype) @ w_out


def setup_inputs(seed: int = 0) -> dict:
    key = jax.random.key(seed)
    ks = jax.random.split(key, 20)
    out_scale = (2 * DEPTH) ** -0.5

    def w(k_, shape, fan_in, scale=1.0):
        return jax.random.normal(k_, shape, jnp.float32) * (scale * fan_in ** -0.5)

    def gain(k_, shape):
        return 1.0 + 0.02 * jax.random.normal(k_, shape, jnp.float32)

    gate_bias = jnp.concatenate([
        0.1 * jax.random.normal(ks[17], (N_A_LAYERS, A_HEADS), jnp.float32),
        3.0 + 0.5 * jax.random.normal(ks[18], (N_A_LAYERS, A_HEADS), jnp.float32)], axis=-1)
    return {
        "x": jax.random.normal(ks[0], (BATCH, SEQ, D_MODEL), jnp.float32),
        "ffn1_norm": gain(ks[1], (DEPTH, D_MODEL)),
        "ffn1_w_in": w(ks[2], (DEPTH, D_MODEL, 2 * D_FF), D_MODEL),
        "ffn1_w_out": w(ks[3], (DEPTH, D_FF, D_MODEL), D_FF, out_scale),
        "mix_norm": gain(ks[4], (DEPTH, D_MODEL)),
        "ffn2_norm": gain(ks[5], (DEPTH, D_MODEL)),
        "ffn2_w_in": w(ks[6], (DEPTH, D_MODEL, 2 * D_FF), D_MODEL),
        "ffn2_w_out": w(ks[7], (DEPTH, D_FF, D_MODEL), D_FF, out_scale),
        "a_w_in": w(ks[8], (N_A_LAYERS, D_MODEL, A_IN_COLS), D_MODEL),
        "a_b_gate": gate_bias,
        "a_head_norm": gain(ks[9], (N_A_LAYERS, A_HEADS * A_DV)),
        "a_w_out": w(ks[10], (N_A_LAYERS, A_HEADS * A_DV, D_MODEL), A_HEADS * A_DV, out_scale),
        "kv_norm": gain(ks[11], (D_MODEL,)),
        "kv_w": w(ks[12], (D_MODEL, 2 * B_HEADS * B_DH), D_MODEL),
        "b_w_q": w(ks[13], (N_B_LAYERS, D_MODEL, B_HEADS * B_DH), D_MODEL),
        "b_w_out": w(ks[14], (N_B_LAYERS, B_HEADS * B_DH, D_MODEL), B_HEADS * B_DH, out_scale),
        "final_norm": gain(ks[15], (D_MODEL,)),
    }


def reference(x, ffn1_norm, ffn1_w_in, ffn1_w_out, mix_norm, ffn2_norm, ffn2_w_in, ffn2_w_out,
              a_w_in, a_b_gate, a_head_norm, a_w_out, kv_norm, kv_w, b_w_q, b_w_out, final_norm):
    k_sh, v_sh = None, None
    for l in range(DEPTH):
        x = x + 0.5 * swiglu(rms_norm(x, ffn1_norm[l]), ffn1_w_in[l], ffn1_w_out[l])
        hn = rms_norm(x, mix_norm[l])
        if l < N_A_LAYERS:
            x = x + mlstm_mix(hn, a_w_in[l], a_b_gate[l], a_head_norm[l], a_w_out[l])
        else:
            j = l - N_A_LAYERS
            x = x + stick_breaking_mix(hn, b_w_q[j], k_sh, v_sh, b_w_out[j])
        x = x + 0.5 * swiglu(rms_norm(x, ffn2_norm[l]), ffn2_w_in[l], ffn2_w_out[l])
        if l == N_A_LAYERS - 1:
            k_sh, v_sh = shared_kv(x, kv_norm, kv_w)
    return rms_norm(x, final_norm)
```

```cpp
#include <hip/hip_runtime.h>
#include <cstdio>
#include <cstdint>
namespace pg8 {
#define PG8_LAS __attribute__((address_space(3)))
typedef unsigned short bf16_t;
typedef short bf16x8 __attribute__((ext_vector_type(8)));
typedef float f32x4 __attribute__((ext_vector_type(4)));
typedef unsigned u32x4 __attribute__((ext_vector_type(4)));
constexpr int BM = 256, BK = 64, HALF = 128, HTB = HALF * BK * 2  , STAGE_BYTES = 8 * HTB, NXCD = 8, WGM = 8;

__host__ __device__ __forceinline__ int lds_byte(int r, int c) { const int st = (r >> 4) * 2 + (c >> 5), rr = r & 15, cc = c & 31, ob = rr * 64 + cc * 2; return st * 1024 + (ob ^ (((ob >> 9) & 1) << 5)); }
__host__ __device__ __forceinline__ void stage_rc(int b, int& R, int& C) { const int st = b / 1024, sb = b % 1024, swz = sb ^ (((sb >> 9) & 1) << 5); R = (st >> 1) * 16 + swz / 64; C = (st & 1) * 32 + (swz % 64) / 2; }
__host__ __device__ __forceinline__ int perm32(int rho) { const int n = rho >> 4, i = rho & 15; return 8 * (i >> 2) + 4 * n + (i & 3); }

struct Unit { int pm, pn; };
struct Gemm { const bf16_t* A; const bf16_t* Bt; int M, N, K; };

struct StaticOrder {
    int nM, nN, nwg, G, c;
    __host__ __device__ void init(int M, int N, int G_, int c_) { nM = M / BM; nN = N / BM; nwg = nM * nN; G = G_; c = c_; }
    __host__ __device__ bool next(int i, Unit& u) const {
        const long L = (long)i * G + c; if (L >= nwg) return false;
        int wgid = (int)L; { const int q = nwg / NXCD, r = nwg % NXCD, xcd = wgid % NXCD, off = wgid / NXCD; wgid = (xcd < r ? xcd * (q + 1) : r * (q + 1) + (xcd - r) * q) + off; }
        const int nig = WGM * nN, gid = wgid / nig, fm = gid * WGM, gsz = (nM - fm) < WGM ? (nM - fm) : WGM;
        u.pm = fm + ((wgid % nig) % gsz); u.pn = (wgid % nig) / gsz; return true;
    }
    __device__ __forceinline__ void a_ready(const Unit&) const {}
    __device__ __forceinline__ void done(const Unit&) const {}
};
__device__ __forceinline__ unsigned cvt_pk_bf16(float lo, float hi) { unsigned r; asm volatile("v_cvt_pk_bf16_f32 %0, %1, %2" : "=v"(r) : "v"(lo), "v"(hi)); return r; }
struct EpiBf16 {
    static constexpr bool PERM = true, AFTER_DRAIN = false;
    bf16_t* O; int ldc; int scale_cols; float sc;
    __device__ __forceinline__ void operator()(const f32x4 (&acc)[2][2][4][2], const Unit& u, int wr, int wc, int fr, int fq) const {
        const int row0 = u.pm * BM + wr * 64 + fr, col0 = u.pn * BM + wc * 32 + 8 * fq;
        const float s = (u.pn * BM < scale_cols) ? sc : 1.0f;
#pragma unroll
        for (int ai = 0; ai < 2; ++ai)
#pragma unroll
            for (int m = 0; m < 4; ++m) { bf16_t* rowp = O + (size_t)(row0 + ai * HALF + m * 16) * ldc + col0;
#pragma unroll
                for (int bj = 0; bj < 2; ++bj) { const f32x4 v0 = acc[ai][bj][m][0] * s, v1 = acc[ai][bj][m][1] * s;
                    u32x4 w; w.x = cvt_pk_bf16(v0[0], v0[1]); w.y = cvt_pk_bf16(v0[2], v0[3]); w.z = cvt_pk_bf16(v1[0], v1[1]); w.w = cvt_pk_bf16(v1[2], v1[3]);
                    *(u32x4*)(rowp + bj * HALF) = w; } }
    }
};
__device__ __forceinline__ float silu_mul(float g, float up) { return g * up * __builtin_amdgcn_rcpf(1.0f + __builtin_amdgcn_exp2f(-1.4426950408889634f * g)); }
struct EpiSwiGLU {
    static constexpr bool PERM = true, AFTER_DRAIN = false;
    bf16_t* O; int ldc;
    __device__ __forceinline__ void operator()(const f32x4 (&acc)[2][2][4][2], const Unit& u, int wr, int wc, int fr, int fq) const {
        const int row0 = u.pm * BM + wr * 64 + fr, col0 = u.pn * HALF + wc * 32 + 8 * fq;
#pragma unroll
        for (int ai = 0; ai < 2; ++ai)
#pragma unroll
            for (int m = 0; m < 4; ++m) { bf16_t* rowp = O + (size_t)(row0 + ai * HALF + m * 16) * ldc + col0;
                const f32x4 g0 = acc[ai][0][m][0], g1 = acc[ai][0][m][1], u0 = acc[ai][1][m][0], u1 = acc[ai][1][m][1];
                u32x4 w; w.x = cvt_pk_bf16(silu_mul(g0[0], u0[0]), silu_mul(g0[1], u0[1])); w.y = cvt_pk_bf16(silu_mul(g0[2], u0[2]), silu_mul(g0[3], u0[3]));
                w.z = cvt_pk_bf16(silu_mul(g1[0], u1[0]), silu_mul(g1[1], u1[1])); w.w = cvt_pk_bf16(silu_mul(g1[2], u1[2]), silu_mul(g1[3], u1[3]));
                *(u32x4*)rowp = w; }
    }
};
struct EpiRes {
    static constexpr bool PERM = false, AFTER_DRAIN = false;
    const float* base; float* out; int ldc; float sc;
    __device__ __forceinline__ void operator()(const f32x4 (&acc)[2][2][4][2], const Unit& u, int wr, int wc, int fr, int fq) const {
        const int row0 = u.pm * BM + wr * 64 + fr, col0 = u.pn * BM + wc * 32 + 4 * fq;
#pragma unroll
        for (int ai = 0; ai < 2; ++ai)
#pragma unroll
            for (int m = 0; m < 4; ++m) { const size_t off = (size_t)(row0 + ai * HALF + m * 16) * ldc + col0;
#pragma unroll
                for (int bj = 0; bj < 2; ++bj)
#pragma unroll
                    for (int n = 0; n < 2; ++n) { const f32x4 bs = *(const f32x4*)(base + off + bj * HALF + n * 16); *(f32x4*)(out + off + bj * HALF + n * 16) = bs + acc[ai][bj][m][n] * sc; }
                asm volatile("" ::: "memory"); }
    }
};
template <class Epi, class Sched, bool ALIGN_EPI = false, bool SP2 = false>
__device__ __forceinline__ void gemm_phase(PG8_LAS unsigned char* lds, const Gemm g, const Sched& S, const Epi& E) {
    int tid_ = threadIdx.x; asm volatile("" : "+v"(tid_));
    const int tid = tid_, wid = __builtin_amdgcn_readfirstlane(tid >> 6), lane = tid & 63, wr = wid >> 2, wc = wid & 3, fr = lane & 15, fq = lane >> 4;
    const int K = g.K, nt = K / BK;
    unsigned voffA[2], voffB[2];
#pragma unroll
    for (int i = 0; i < 2; ++i) { int R, C; stage_rc(tid * 16 + i * 8192, R, C); const int Rb = Epi::PERM ? ((R & ~31) + perm32(R & 31)) : R;
        voffA[i] = (unsigned)(R * K + C) * 2u; voffB[i] = (unsigned)(Rb * K + C) * 2u; }
    const size_t kstep = (size_t)(BK * 2);
    const size_t hstep = (size_t)HALF * K * 2;
    const size_t tstep = 2 * hstep;
    const unsigned ldsw = (unsigned)wid * 1024u;
    const int aoff = lds_byte(wr * 64 + fr, fq * 8), boff = lds_byte(wc * 32 + fr, fq * 8);
#define PG8_SA(b, h) (((b) * 2 + (h)) * HTB)
#define PG8_SB(b, h) ((4 + (b) * 2 + (h)) * HTB)
#define PG8_STAGE(bufoff, gbase, voff) do { _Pragma("unroll") for (int _i = 0; _i < 2; ++_i) \
        __builtin_amdgcn_global_load_lds((const unsigned*)((const char*)(gbase) + (voff)[_i]), (PG8_LAS unsigned*)(lds + (bufoff) + ldsw + _i * 8192), 16, 0, 0); } while (0)
#define PG8_LDA(dst, b, h) do { _Pragma("unroll") for (int m = 0; m < 4; ++m) _Pragma("unroll") for (int k = 0; k < 2; ++k) dst[m][k] = *(const PG8_LAS bf16x8*)(lds + PG8_SA(b, h) + aoff + m * 2048 + k * 1024); } while (0)
#define PG8_LDB(dst, b, h) do { _Pragma("unroll") for (int n = 0; n < 2; ++n) _Pragma("unroll") for (int k = 0; k < 2; ++k) dst[n][k] = *(const PG8_LAS bf16x8*)(lds + PG8_SB(b, h) + boff + n * 2048 + k * 1024); } while (0)
#define PG8_MMA(ai, bj, At, Bt) do { __builtin_amdgcn_s_setprio(1); _Pragma("unroll") for (int m = 0; m < 4; ++m) _Pragma("unroll") for (int n = 0; n < 2; ++n) _Pragma("unroll") for (int k = 0; k < 2; ++k) \
        acc[ai][bj][m][n] = __builtin_amdgcn_mfma_f32_16x16x32_bf16(Bt[n][k], At[m][k], acc[ai][bj][m][n], 0, 0, 0); __builtin_amdgcn_s_setprio(0); } while (0)
#define PG8_WAIT_V(n) asm volatile("s_waitcnt vmcnt(" #n ")" ::: "memory")
#define PG8_WAIT_L(n) asm volatile("s_waitcnt lgkmcnt(" #n ")" ::: "memory")
#define PG8_BAR __builtin_amdgcn_s_barrier()
#define PG8_SCHED __builtin_amdgcn_sched_barrier(0)
    Unit cur, nxt; int ui = 0;
    if (!S.next(0, cur)) return;
    f32x4 acc[2][2][4][2];
#pragma unroll
    for (int a = 0; a < 2; ++a)
#pragma unroll
        for (int b = 0; b < 2; ++b)
#pragma unroll
            for (int m = 0; m < 4; ++m)
#pragma unroll
                for (int n = 0; n < 2; ++n) acc[a][b][m][n] = (f32x4){0.f, 0.f, 0.f, 0.f};
    bf16x8 At[4][2], B0[2][2], B1[2][2];
    const char* cA = (const char*)g.A + (size_t)cur.pm * tstep; const char* cB = (const char*)g.Bt + (size_t)cur.pn * tstep;
    S.a_ready(cur);
    if constexpr (SP2) {
        PG8_STAGE(PG8_SB(0, 0), cB, voffB); PG8_STAGE(PG8_SB(0, 1), cB + hstep, voffB); PG8_STAGE(PG8_SA(0, 0), cA, voffA); PG8_STAGE(PG8_SA(0, 1), cA + hstep, voffA);
        if (wr == 1) PG8_BAR;
        PG8_WAIT_V(2); PG8_BAR;
        PG8_STAGE(PG8_SB(1, 0), cB + kstep, voffB); PG8_STAGE(PG8_SA(1, 0), cA + kstep, voffA); PG8_STAGE(PG8_SB(1, 1), cB + hstep + kstep, voffB);
        PG8_WAIT_V(6); PG8_BAR;
    } else {
        PG8_STAGE(PG8_SB(0, 0), cB, voffB); PG8_STAGE(PG8_SA(0, 0), cA, voffA); PG8_STAGE(PG8_SB(0, 1), cB + hstep, voffB); PG8_STAGE(PG8_SA(0, 1), cA + hstep, voffA);
        if (wr == 1) PG8_BAR;
        PG8_WAIT_V(4); PG8_BAR;
        PG8_STAGE(PG8_SB(1, 0), cB + kstep, voffB); PG8_STAGE(PG8_SA(1, 0), cA + kstep, voffA); PG8_STAGE(PG8_SB(1, 1), cB + hstep + kstep, voffB);
        PG8_WAIT_V(6); PG8_BAR;
    }
    for (;;) {
        const bool has_next = S.next(ui + 1, nxt);
        const char* nA = has_next ? (const char*)g.A + (size_t)nxt.pm * tstep : cA; const char* nB = has_next ? (const char*)g.Bt + (size_t)nxt.pn * tstep : cB;
        for (int t = 0; t < nt; t += 2) {
            const bool last = (t == nt - 2);
            const char* a1 = cA + (size_t)(t + 1) * kstep;
            const char* a2 = last ? nA : cA + (size_t)(t + 2) * kstep; const char* b2 = last ? nB : cB + (size_t)(t + 2) * kstep;
            const char* a3 = a2 + kstep; const char* b3 = b2 + kstep;
            if (last && has_next) S.a_ready(nxt);
            if constexpr (SP2) {
            PG8_LDB(B0, 0, 0); PG8_LDB(B1, 0, 1); PG8_SCHED; PG8_LDA(At, 0, 0); PG8_STAGE(PG8_SA(1, 1), a1 + hstep, voffA);
            PG8_WAIT_V(8); PG8_WAIT_L(0); PG8_BAR; PG8_MMA(0, 0, At, B0); PG8_MMA(0, 1, At, B1); PG8_BAR; PG8_SCHED;
            PG8_LDA(At, 0, 1); PG8_STAGE(PG8_SB(0, 0), b2, voffB); PG8_STAGE(PG8_SB(0, 1), b2 + hstep, voffB); PG8_STAGE(PG8_SA(0, 0), a2, voffA);
            PG8_WAIT_V(8); PG8_WAIT_L(0); PG8_BAR; PG8_MMA(1, 0, At, B0); PG8_MMA(1, 1, At, B1); PG8_BAR; PG8_SCHED;
            PG8_LDB(B0, 1, 0); PG8_LDB(B1, 1, 1); PG8_SCHED; PG8_LDA(At, 1, 0); PG8_STAGE(PG8_SA(0, 1), a2 + hstep, voffA);
            PG8_WAIT_V(8); PG8_WAIT_L(0); PG8_BAR; PG8_MMA(0, 0, At, B0); PG8_MMA(0, 1, At, B1); PG8_BAR; PG8_SCHED;
            PG8_LDA(At, 1, 1); PG8_STAGE(PG8_SB(1, 0), b3, voffB); PG8_STAGE(PG8_SB(1, 1), b3 + hstep, voffB); PG8_STAGE(PG8_SA(1, 0), a3, voffA);
            PG8_WAIT_V(8); PG8_WAIT_L(0); PG8_BAR; PG8_MMA(1, 0, At, B0); PG8_MMA(1, 1, At, B1); PG8_BAR; PG8_SCHED;
            } else {
            PG8_LDB(B0, 0, 0); PG8_SCHED; PG8_LDA(At, 0, 0); PG8_STAGE(PG8_SA(1, 1), a1 + hstep, voffA);
            PG8_WAIT_L(8); PG8_BAR; PG8_WAIT_L(0); PG8_MMA(0, 0, At, B0); PG8_BAR; PG8_SCHED;
            PG8_LDB(B1, 0, 1); PG8_STAGE(PG8_SB(0, 0), b2, voffB);
            PG8_BAR; PG8_WAIT_L(0); PG8_MMA(0, 1, At, B1); PG8_BAR;
            PG8_LDA(At, 0, 1); PG8_STAGE(PG8_SA(0, 0), a2, voffA);
            PG8_BAR; PG8_WAIT_L(0); PG8_MMA(1, 0, At, B0); PG8_BAR; PG8_SCHED;
            PG8_STAGE(PG8_SB(0, 1), b2 + hstep, voffB);
            PG8_WAIT_V(6); PG8_BAR; PG8_MMA(1, 1, At, B1); PG8_BAR;
            PG8_LDB(B0, 1, 0); PG8_SCHED; PG8_LDA(At, 1, 0); PG8_STAGE(PG8_SA(0, 1), a2 + hstep, voffA);
            PG8_WAIT_L(8); PG8_BAR; PG8_WAIT_L(0); PG8_MMA(0, 0, At, B0); PG8_BAR; PG8_SCHED;
            PG8_LDB(B1, 1, 1); PG8_STAGE(PG8_SB(1, 0), b3, voffB);
            PG8_BAR; PG8_WAIT_L(0); PG8_MMA(0, 1, At, B1); PG8_BAR;
            PG8_LDA(At, 1, 1); PG8_STAGE(PG8_SA(1, 0), a3, voffA);
            PG8_BAR; PG8_WAIT_L(0); PG8_MMA(1, 0, At, B0); PG8_BAR; PG8_SCHED;
            PG8_STAGE(PG8_SB(1, 1), b3 + hstep, voffB);
            PG8_WAIT_V(6); PG8_BAR; PG8_MMA(1, 1, At, B1); PG8_BAR;
            }
        }
        if constexpr (ALIGN_EPI) { if (wr == 0) PG8_BAR; }
        if constexpr (!Epi::AFTER_DRAIN) { E(acc, cur, wr, wc, fr, fq); S.done(cur); }
        if (!has_next) break;
#pragma unroll
        for (int a = 0; a < 2; ++a)
#pragma unroll
            for (int b = 0; b < 2; ++b)
#pragma unroll
                for (int m = 0; m < 4; ++m)
#pragma unroll
                    for (int n = 0; n < 2; ++n) acc[a][b][m][n] = (f32x4){0.f, 0.f, 0.f, 0.f};
        cur = nxt; cA = nA; cB = nB; ++ui;
        if constexpr (ALIGN_EPI) { if (wr == 1) PG8_BAR; }
    }
    PG8_WAIT_V(0);
    if constexpr (!ALIGN_EPI) { if (wr == 0) PG8_BAR; }
    PG8_BAR;
    if constexpr (Epi::AFTER_DRAIN) { E.fused(acc, cur, wr, wc, fr, fq, lds, wid, lane); S.done(cur); }
#undef PG8_SA
#undef PG8_SB
#undef PG8_STAGE
#undef PG8_LDA
#undef PG8_LDB
#undef PG8_MMA
#undef PG8_WAIT_V
#undef PG8_WAIT_L
#undef PG8_BAR
#undef PG8_SCHED
}
}
constexpr int D = 2048, BATCH = 4, SEQ = 2048, M = BATCH * SEQ, DFF = 5632;
constexpr int A_H = 8, A_DV = 256, A_DQK = 128, A_L = 64, A_NC = SEQ / A_L, A_INC = 6160;
constexpr int B_H = 16, B_DH = 128;
constexpr float EPS = 1e-6f, LOG2E = 1.4426950408889634f;
constexpr int NWAVES = 8;

constexpr size_t MiB = 1u << 20;
constexpr size_t WS_CTL = 0, CTL_BYTES = 1 * MiB;
constexpr size_t WS_WG = 1 * MiB;
constexpr size_t WS_GATES = 2 * MiB;
constexpr size_t WS_DN = 3 * MiB;
constexpr size_t WS_FFN = 4 * MiB;
constexpr size_t W1_BYTES = 44 * MiB, FFN_BYTES = 66 * MiB;
constexpr size_t WS_AW = WS_FFN + 8 * FFN_BYTES;
constexpr size_t WS_KVK = WS_AW + 64 * MiB, WS_KVV = WS_KVK + 8 * MiB;
constexpr size_t WS_BQ = WS_KVV + 8 * MiB, WS_BO = WS_BQ + 16 * MiB;
constexpr size_t WS_X = WS_BO + 16 * MiB;
constexpr size_t WS_XN = WS_X + 64 * MiB;
constexpr size_t WS_KB = WS_XN + 32 * MiB;
constexpr size_t WS_VTB = WS_KB + 32 * MiB;
constexpr size_t WS_SCR = WS_VTB + 32 * MiB;
constexpr size_t SCR_ACT = 0;
constexpr size_t SCR_PROJ = 0, SCR_VTA = 64 * MiB, SCR_HSNUM = 96 * MiB, SCR_HS = 160 * MiB;
constexpr size_t SCR_Q = 0, SCR_O = 32 * MiB;
constexpr size_t WS_END = WS_SCR + 256 * MiB;
constexpr int CW_BAR = 4096;

constexpr int LDS_BYTES = 147456;
constexpr int LDSCTL_OFF = 143360;
constexpr int P0_JOBS_OFF = 73728;

#define GAS __attribute__((address_space(1)))
#define LAS __attribute__((address_space(3)))
typedef unsigned short bf16;
typedef unsigned v4u __attribute__((ext_vector_type(4)));
typedef unsigned v2u __attribute__((ext_vector_type(2)));
typedef float f32x4 __attribute__((ext_vector_type(4)));
typedef float f32x2 __attribute__((ext_vector_type(2)));
typedef short bf16x8 __attribute__((ext_vector_type(8)));
typedef __bf16 nbf16x2 __attribute__((ext_vector_type(2)));
#define LDS_WAIT() asm volatile("s_waitcnt lgkmcnt(0)" ::: "memory")
#define MFMA16(a, b, c) __builtin_amdgcn_mfma_f32_16x16x32_bf16((a), (b), (c), 0, 0, 0)
__device__ __forceinline__ unsigned pk2(float lo, float hi) { f32x2 v = {lo, hi}; return __builtin_bit_cast(unsigned, __builtin_convertvector(v, nbf16x2)); }
__device__ __forceinline__ float bflo(unsigned w) { return __builtin_bit_cast(float, w << 16); }
__device__ __forceinline__ float bfhi(unsigned w) { return __builtin_bit_cast(float, w & 0xffff0000u); }
__device__ __forceinline__ float wave_sum(float v) {
#pragma unroll
    for (int o = 1; o < 64; o <<= 1) v += __shfl_xor(v, o);
    return v;
}
#define PHASE_IDS int tid = threadIdx.x; asm volatile("" : "+v"(tid)); const int lane = tid & 63, wave = __builtin_amdgcn_readfirstlane(tid >> 6); \
    const int G = gridDim.x, vcu = (G % 8 == 0) ? ((int)blockIdx.x % 8) * (G / 8) + (int)blockIdx.x / 8 : (int)blockIdx.x; (void)lane; (void)wave; (void)vcu; (void)G;
#define XB_TMO      128
#define XB_XCNT(j)  (256  + 64 * (j))
#define XB_XSUB(j)  (1280 + 64 * (j))
#define XB_XGEN(j)  (2304 + 64 * (j))
#define XB_TOP      3328
#define XB_TOPGEN   3392
#define XCD_BAR_WORDS 3456
#define XB_SPIN_CAP (1u << 18)
#define LAS __attribute__((address_space(3)))

__device__ __forceinline__ unsigned xb_ld(unsigned* p)              { return __hip_atomic_load(p, __ATOMIC_RELAXED, __HIP_MEMORY_SCOPE_AGENT); }
__device__ __forceinline__ unsigned xb_add(unsigned* p, unsigned v) { return __hip_atomic_fetch_add(p, v, __ATOMIC_RELAXED, __HIP_MEMORY_SCOPE_AGENT); }
__device__ __forceinline__ unsigned xb_xcc_id() { return (unsigned)__builtin_amdgcn_s_getreg((3 << 11) | 20) & 0xFu; }
#define XB_SPIN(cond, bar) do { unsigned _sp = 0; while (cond) { __builtin_amdgcn_s_sleep(1); \
    if ((++_sp & 255u) == 0u) { if (xb_ld(&(bar)[XB_TMO])) break; if (_sp > XB_SPIN_CAP) { atomicAdd(&(bar)[XB_TMO], 1u); break; } } } } while (0)

struct XcdBarrier {
    unsigned* bar; unsigned x;
    volatile LAS unsigned* st;
};

__device__ __forceinline__ XcdBarrier xcd_barrier_post(unsigned* bar, volatile LAS unsigned* st) {
    XcdBarrier b; b.bar = bar; b.x = xb_xcc_id(); b.st = st;
    if (threadIdx.x == 0) (void)xb_add(&bar[XB_XCNT(b.x)], 1u);
    return b;
}
__device__ __forceinline__ void xcd_barrier_complete(unsigned* bar, unsigned x, unsigned& nloc, unsigned& nx) {
    const unsigned G = gridDim.x * gridDim.y * gridDim.z;
    unsigned sum, cnt, mine, sp = 0u;
    for (;;) {
        sum = 0u; cnt = 0u; mine = 0u;
#pragma unroll
        for (unsigned j = 0; j < 16; ++j) { const unsigned c = xb_ld(&bar[XB_XCNT(j)]); sum += c; cnt += (c > 0u) ? 1u : 0u; mine = (j == x) ? c : mine; }
        if (sum == G) break;
        __builtin_amdgcn_s_sleep(1);
        if ((++sp & 255u) == 0u) { if (xb_ld(&bar[XB_TMO])) break; if (sp > XB_SPIN_CAP) { atomicAdd(&bar[XB_TMO], 1u); break; } }
    }
    nloc = mine > 0u ? mine : 1u; nx = cnt > 0u ? cnt : 1u;
}

__device__ __forceinline__ void xcd_barrier(const XcdBarrier& b) {
    asm volatile("s_waitcnt vmcnt(0)" ::: "memory");
    __syncthreads();
    if (threadIdx.x == 0) {
        unsigned* bar = b.bar;
        __builtin_amdgcn_s_waitcnt(0);
        unsigned nloc = b.st[0], nx = b.st[1];
        if (nloc == 0u) { xcd_barrier_complete(bar, b.x, nloc, nx); b.st[0] = nloc; b.st[1] = nx; }
        const unsigned old = xb_add(&bar[XB_XSUB(b.x)], 1u);
        const unsigned gen = old / nloc;
        if (old + 1u == (gen + 1u) * nloc) {
            __builtin_amdgcn_fence(__ATOMIC_RELEASE, "agent");
            asm volatile("s_waitcnt vmcnt(0)" ::: "memory");
            const unsigned og = xb_add(&bar[XB_TOP], 1u);
            const unsigned tg = og / nx;
            if (og + 1u == (tg + 1u) * nx) xb_add(&bar[XB_TOPGEN], 1u);
            else XB_SPIN(xb_ld(&bar[XB_TOPGEN]) == tg, bar);
            __builtin_amdgcn_fence(__ATOMIC_ACQUIRE, "agent");
            xb_add(&bar[XB_XGEN(b.x)], 1u);
            asm volatile("s_waitcnt vmcnt(0)" ::: "memory");
        } else {
            XB_SPIN(xb_ld(&bar[XB_XGEN(b.x)]) == gen, bar);
            __builtin_amdgcn_fence(__ATOMIC_ACQUIRE, "agent");
            asm volatile("s_waitcnt vmcnt(0)" ::: "memory");
        }
    }
    __syncthreads();
}
struct Frame { LAS unsigned char* lds; };

struct Job { const float* src; bf16* dst; int ldw, K, c0, nblk, perm, start; };
__device__ __forceinline__ void put_job(LAS Job* J, int& nj, int& start, const float* src, bf16* dst, int ldw, int K, int c0, int ncols, int perm) {
    J[nj].src = src; J[nj].dst = dst; J[nj].ldw = ldw; J[nj].K = K; J[nj].c0 = c0; J[nj].nblk = ncols / 32; J[nj].perm = perm; J[nj].start = start;
    start += (K / 64) * (ncols / 32); ++nj;
}
__device__ __forceinline__ void cvt_item(const float* W, int ldw, int K, bf16* WT, int k0, LAS float* scr, int lane) {
#pragma unroll 16
    for (int i = 0; i < 32; ++i) { const int kk = 2 * i + (lane >> 5); scr[kk * 33 + (lane & 31)] = W[(size_t)(k0 + kk) * ldw + (lane & 31)]; }
    LDS_WAIT();
    const int c = lane & 7;
#pragma unroll
    for (int j = 0; j < 4; ++j) { const int n = (lane >> 3) + 8 * j; const LAS float* s = scr + (8 * c) * 33 + n;
        v4u o; o.x = pk2(s[0 * 33], s[1 * 33]); o.y = pk2(s[2 * 33], s[3 * 33]); o.z = pk2(s[4 * 33], s[5 * 33]); o.w = pk2(s[6 * 33], s[7 * 33]);
        *(v4u*)(WT + (size_t)n * K + k0 + 8 * c) = o; }
    LDS_WAIT();
}
struct Ptrs {
    const float* in[17]; float* out; unsigned char* ws;
};
typedef const __attribute__((address_space(4))) Ptrs* KArgs;
__device__ __forceinline__ void p0_convert(const Frame& F, KArgs Pp) {
#define P (*Pp)
    PHASE_IDS
    LAS Job* J = (LAS Job*)(F.lds + P0_JOBS_OFF);
    LAS int* JN = (LAS int*)(F.lds + P0_JOBS_OFF + 40 * 40);
    if (tid == 0) {
        int nj = 0, start = 0; unsigned char* ws = P.ws;
        for (int f = 0; f < 8; ++f) { const int l = f >> 1, which = f & 1;
            const float* win = (which ? P.in[6] : P.in[2]) + (size_t)l * D * (2 * DFF);
            const float* wout = (which ? P.in[7] : P.in[3]) + (size_t)l * DFF * D;
            put_job(J, nj, start, win, (bf16*)(ws + WS_FFN + f * FFN_BYTES), 2 * DFF, D, 0, 2 * DFF, 1);
            put_job(J, nj, start, wout, (bf16*)(ws + WS_FFN + f * FFN_BYTES + W1_BYTES), D, DFF, 0, D, 0); }
        for (int l = 0; l < 2; ++l) { const float* w = P.in[8] + (size_t)l * D * A_INC; unsigned char* base = ws + WS_AW + (size_t)l * 32 * MiB;
            put_job(J, nj, start, w, (bf16*)base, A_INC, D, 0, 2048, 0);
            put_job(J, nj, start, w, (bf16*)base + (size_t)2048 * D, A_INC, D, 4096, 2048, 0);
            put_job(J, nj, start, w, (bf16*)(base + 16 * MiB), A_INC, D, 2048, 2048, 0);
            put_job(J, nj, start, P.in[11] + (size_t)l * D * D, (bf16*)(base + 24 * MiB), D, D, 0, D, 0); }
        put_job(J, nj, start, P.in[13], (bf16*)(ws + WS_KVK), 2 * D, D, 0, D, 0);
        put_job(J, nj, start, P.in[13], (bf16*)(ws + WS_KVV), 2 * D, D, D, D, 0);
        for (int j = 0; j < 2; ++j) {
            put_job(J, nj, start, P.in[14] + (size_t)j * D * D, (bf16*)(ws + WS_BQ + (size_t)j * 8 * MiB), D, D, 0, D, 0);
            put_job(J, nj, start, P.in[15] + (size_t)j * D * D, (bf16*)(ws + WS_BO + (size_t)j * 8 * MiB), D, D, 0, D, 0); }
        JN[0] = nj; JN[1] = start;
        J[nj].start = start;
    }
    __syncthreads();
    const int nj = JN[0], total = JN[1];
    LAS float* scr = (LAS float*)(F.lds + wave * 8448);
    const int gw = vcu * NWAVES + wave, NGW = G * NWAVES;
    int j = 0;
    for (int it = gw; it < total; it += NGW) {
        while (j + 1 < nj && it >= J[j + 1].start) ++j;
        const int local = it - J[j].start, nblk = J[j].nblk, nb = local % nblk, kb = local / nblk, n0 = 32 * nb, K = J[j].K;
        int sc = n0;
        if (J[j].perm) { const int t = n0 >> 8, c = n0 & 255; sc = (c < 128) ? (128 * t + c) : (DFF + 128 * t + (c - 128)); }
        cvt_item(J[j].src + J[j].c0 + sc, J[j].ldw, K, J[j].dst + (size_t)n0 * K, 64 * kb, scr, lane);
    }
    { float* wg = (float*)(P.ws + WS_WG);
      for (int i = (vcu * NWAVES + wave) * 64 + lane; i < 2 * D * 16; i += G * NWAVES * 64) { const int l = i >> 15, k = (i >> 4) & (D - 1), jj = i & 15;
          wg[i] = P.in[8][(size_t)l * D * A_INC + (size_t)k * A_INC + 6144 + jj]; } }
    __syncthreads();
#undef P
}

__device__ __forceinline__ void norm_phase(const Frame& F, const float* xin, const float* gain, bf16* xn, bool gates, const float* wg, const float* bg, float* gout) {
    PHASE_IDS
    const int gw = vcu * NWAVES + wave, NGW = G * NWAVES;
    f32x4 gv[8];
#pragma unroll
    for (int j = 0; j < 8; ++j) gv[j] = *(const f32x4*)(gain + 256 * j + 4 * lane);
    for (int m = gw; m < M; m += NGW) {
        const f32x4* xr = (const f32x4*)(xin + (size_t)m * D) + lane;
        f32x4 v[8]; float s = 0.f;
#pragma unroll
        for (int j = 0; j < 8; ++j) { v[j] = xr[64 * j]; s += (v[j].x * v[j].x + v[j].y * v[j].y) + (v[j].z * v[j].z + v[j].w * v[j].w); }
        const float rstd = 1.0f / sqrtf(wave_sum(s) * (1.0f / D) + EPS);
        v2u* o8 = (v2u*)(xn + (size_t)m * D) + lane;
#pragma unroll
        for (int j = 0; j < 8; ++j) { v[j] = v[j] * rstd * gv[j]; v2u w; w.x = pk2(v[j].x, v[j].y); w.y = pk2(v[j].z, v[j].w); o8[64 * j] = w; }
        if (gates) {
            float acc[16];
#pragma unroll
            for (int q = 0; q < 16; ++q) acc[q] = 0.f;
#pragma unroll
            for (int j = 0; j < 8; ++j)
#pragma unroll
                for (int c = 0; c < 4; ++c) { const int k = 256 * j + 4 * lane + c; const f32x4* wp = (const f32x4*)(wg + (size_t)k * 16); const float y = v[j][c];
                    const f32x4 w0 = wp[0], w1 = wp[1], w2 = wp[2], w3 = wp[3];
                    acc[0] += y * w0.x; acc[1] += y * w0.y; acc[2] += y * w0.z; acc[3] += y * w0.w; acc[4] += y * w1.x; acc[5] += y * w1.y; acc[6] += y * w1.z; acc[7] += y * w1.w;
                    acc[8] += y * w2.x; acc[9] += y * w2.y; acc[10] += y * w2.z; acc[11] += y * w2.w; acc[12] += y * w3.x; acc[13] += y * w3.y; acc[14] += y * w3.z; acc[15] += y * w3.w; }
            float r8[8], r4[4], r2[2], r1;
            { const bool up = (lane & 32) != 0;
#pragma unroll
              for (int i = 0; i < 8; ++i) { const float keep = up ? acc[i + 8] : acc[i], send = up ? acc[i] : acc[i + 8]; r8[i] = keep + __shfl_xor(send, 32); } }
            { const bool up = (lane & 16) != 0;
#pragma unroll
              for (int i = 0; i < 4; ++i) { const float keep = up ? r8[i + 4] : r8[i], send = up ? r8[i] : r8[i + 4]; r4[i] = keep + __shfl_xor(send, 16); } }
            { const bool up = (lane & 8) != 0;
#pragma unroll
              for (int i = 0; i < 2; ++i) { const float keep = up ? r4[i + 2] : r4[i], send = up ? r4[i] : r4[i + 2]; r2[i] = keep + __shfl_xor(send, 8); } }
            { const bool up = (lane & 4) != 0; const float keep = up ? r2[1] : r2[0], send = up ? r2[0] : r2[1]; r1 = keep + __shfl_xor(send, 4); }
            r1 += __shfl_xor(r1, 1); r1 += __shfl_xor(r1, 2);
            if ((lane & 3) == 0) { const int jj = ((lane >> 5) & 1) * 8 + ((lane >> 4) & 1) * 4 + ((lane >> 3) & 1) * 2 + ((lane >> 2) & 1);
                const float gpre = r1 + bg[jj]; float val;
                if (jj < 8) val = 15.0f * tanhf(gpre * (1.0f / 15.0f));
                else val = fminf(gpre, 0.f) - log1pf(expf(-fabsf(gpre)));
                gout[(size_t)m * 16 + jj] = val; }
        }
    }
}
__device__ __forceinline__ void final_norm_phase(const Frame& F, const float* xin, const float* gain, float* out) {
    PHASE_IDS
    const int gw = vcu * NWAVES + wave, NGW = G * NWAVES;
    f32x4 gv[8];
#pragma unroll
    for (int j = 0; j < 8; ++j) gv[j] = *(const f32x4*)(gain + 256 * j + 4 * lane);
    for (int m = gw; m < M; m += NGW) {
        const f32x4* xr = (const f32x4*)(xin + (size_t)m * D) + lane;
        f32x4 v[8]; float s = 0.f;
#pragma unroll
        for (int j = 0; j < 8; ++j) { v[j] = xr[64 * j]; s += (v[j].x * v[j].x + v[j].y * v[j].y) + (v[j].z * v[j].z + v[j].w * v[j].w); }
        const float rstd = 1.0f / sqrtf(wave_sum(s) * (1.0f / D) + EPS);
        f32x4* o = (f32x4*)(out + (size_t)m * D) + lane;
#pragma unroll
        for (int j = 0; j < 8; ++j) o[64 * j] = v[j] * rstd * gv[j];
    }
}
__device__ __forceinline__ void mlstm_finalize_phase(const Frame& F, const float* num, const float* dn, const bf16* proj, const float* hgain, bf16* hs) {
    PHASE_IDS
    const int gw = vcu * NWAVES + wave, NGW = G * NWAVES;
    for (int m = gw; m < M; m += NGW) {
#pragma unroll
        for (int h = 0; h < A_H; ++h) {
            const f32x4 nv = *(const f32x4*)(num + (size_t)m * 2048 + h * 256 + 4 * lane);
            const float rd = 1.0f / dn[(size_t)m * 8 + h];
            const f32x4 hv = nv * rd;
            const float ss = wave_sum((hv.x * hv.x + hv.y * hv.y) + (hv.z * hv.z + hv.w * hv.w));
            const float r = 1.0f / sqrtf(ss * (1.0f / 256.0f) + EPS);
            const f32x4 g = *(const f32x4*)(hgain + h * 256 + 4 * lane);
            const v2u ogw = *(const v2u*)(proj + (size_t)m * 4096 + 2048 + h * 256 + 4 * lane);
            const float o0 = bflo(ogw.x), o1 = bfhi(ogw.x), o2 = bflo(ogw.y), o3 = bfhi(ogw.y);
            const float y0 = hv.x * r * g.x / (1.0f + __expf(-o0)), y1 = hv.y * r * g.y / (1.0f + __expf(-o1));
            const float y2 = hv.z * r * g.z / (1.0f + __expf(-o2)), y3 = hv.w * r * g.w / (1.0f + __expf(-o3));
            v2u w; w.x = pk2(y0, y1); w.y = pk2(y2, y3);
            *(v2u*)(hs + (size_t)m * 2048 + h * 256 + 4 * lane) = w;
        }
    }
}
constexpr int ML_QS = 272, ML_TS = 144;
constexpr int ML_Q0 = 0, ML_K0 = 34816, ML_KT0 = 69632, ML_VT0 = 106496, ML_SW = 124928, ML_SC0 = 134144, ML_END = 137216;
constexpr int ML_QB = 17408, ML_KTB = 18432, ML_VTB = 9216, ML_SCB = 1536;
constexpr int SC_A2 = 0, SC_U2 = 256, SC_DEC = 512, SC_W = 768, SC_FLOOR = 1024, SC_CDEC = 1280;
static_assert(ML_END <= LDSCTL_OFF, "mLSTM LDS map");

__device__ __forceinline__ float scan_add(float x, int lane) {
#pragma unroll
    for (int o = 1; o < 64; o <<= 1) { const float y = __shfl_up(x, o); if (lane >= o) x += y; }
    return x;
}
__device__ __forceinline__ float scan_max(float x, int lane) {
#pragma unroll
    for (int o = 1; o < 64; o <<= 1) { const float y = __shfl_up(x, o); if (lane >= o) x = fmaxf(x, y); }
    return x;
}
__device__ __forceinline__ float mlstm_scalars(LAS unsigned char* sc, const float* gates, int tok0, int h, int lane, float m) {
    const float ig = gates[(size_t)(tok0 + lane) * 16 + h], lf = gates[(size_t)(tok0 + lane) * 16 + 8 + h];
    const float b = scan_add(lf, lane);
    const float u = ig - b;
    const float pm = scan_max(u, lane);
    const float mx = fmaxf(pm, m);
    const float a63 = -__shfl(mx, 63), b63 = __shfl(b, 63);
    ((LAS float*)(sc + SC_A2))[lane] = -mx * LOG2E;
    ((LAS float*)(sc + SC_U2))[lane] = u * LOG2E;
    ((LAS float*)(sc + SC_DEC))[lane] = __expf(m - mx);
    ((LAS float*)(sc + SC_W))[lane] = __expf(u + a63);
    ((LAS float*)(sc + SC_FLOOR))[lane] = __expf(-(b + mx));
    if (lane == 0) ((LAS float*)(sc + SC_CDEC))[0] = __expf(m + a63);
    return b63 - a63;
}
__device__ __forceinline__ void mlstm_phase(const Frame& F, const bf16* proj, const bf16* vta, const float* gates, float* hsnum, float* dnbuf) {
    if (blockIdx.x >= 128) return;
    PHASE_IDS
    LAS unsigned char* lds = F.lds;
    const int w = wave, l15 = lane & 15, g = lane >> 4;
    const int unit = blockIdx.x, bh = unit >> 2, vs = unit & 3, b = bh >> 3, h = bh & 7;
    const int tokb = b * SEQ;
    const int qrow0 = tid >> 4, qc16 = tid & 15;
    const int vrow_p = tid >> 3, vc16 = tid & 7;
    const bf16* qg = proj + (size_t)(tokb + qrow0) * 4096 + h * 128 + qc16 * 8;
    const bf16* vg = vta + (size_t)(h * 256 + vs * 64 + vrow_p) * M + tokb + vc16 * 8;
    v4u rq[2], rk[2], rv;
#define ML_LOAD(c) do { const size_t _t = (size_t)(c) * A_L; \
        rq[0] = *(const v4u*)(qg + _t * 4096); rq[1] = *(const v4u*)(qg + (_t + 32) * 4096); \
        rk[0] = *(const v4u*)(qg + _t * 4096 + 1024); rk[1] = *(const v4u*)(qg + (_t + 32) * 4096 + 1024); \
        rv = *(const v4u*)(vg + _t); } while (0)
#define ML_STORE(bufi) do { \
        _Pragma("unroll") for (int _i = 0; _i < 2; ++_i) { const int _row = qrow0 + 32 * _i; \
            *(LAS v4u*)(lds + ML_Q0 + (bufi) * ML_QB + _row * ML_QS + qc16 * 16) = rq[_i]; \
            *(LAS v4u*)(lds + ML_K0 + (bufi) * ML_QB + _row * ML_QS + qc16 * 16) = rk[_i]; \
            LAS unsigned char* _kt = lds + ML_KT0 + (bufi) * ML_KTB + (qc16 * 8) * ML_TS + _row * 2; \
            *(LAS bf16*)(_kt + 0 * ML_TS) = (bf16)(rk[_i].x & 0xffffu); *(LAS bf16*)(_kt + 1 * ML_TS) = (bf16)(rk[_i].x >> 16); \
            *(LAS bf16*)(_kt + 2 * ML_TS) = (bf16)(rk[_i].y & 0xffffu); *(LAS bf16*)(_kt + 3 * ML_TS) = (bf16)(rk[_i].y >> 16); \
            *(LAS bf16*)(_kt + 4 * ML_TS) = (bf16)(rk[_i].z & 0xffffu); *(LAS bf16*)(_kt + 5 * ML_TS) = (bf16)(rk[_i].z >> 16); \
            *(LAS bf16*)(_kt + 6 * ML_TS) = (bf16)(rk[_i].w & 0xffffu); *(LAS bf16*)(_kt + 7 * ML_TS) = (bf16)(rk[_i].w >> 16); } \
        *(LAS v4u*)(lds + ML_VT0 + (bufi) * ML_VTB + vrow_p * ML_TS + vc16 * 16) = rv; } while (0)
    float mrun = 0.f;
    ML_LOAD(0); ML_STORE(0);
    if (w == 5) mrun = mlstm_scalars(lds + ML_SC0, gates, tokb, h, lane, mrun);
    f32x4 CT[8];
#pragma unroll
    for (int i = 0; i < 8; ++i) CT[i] = (f32x4){0.f, 0.f, 0.f, 0.f};
    const bool aux = (w == 4);
    const int vrow = 16 * (w & 3) + l15;
    LDS_WAIT(); __syncthreads();
    for (int c = 0; c < A_NC; ++c) {
        const int bf = c & 1, tok0 = tokb + c * A_L;
        LAS unsigned char* sQ = lds + ML_Q0 + bf * ML_QB; LAS unsigned char* sK = lds + ML_K0 + bf * ML_QB;
        LAS unsigned char* sKT = lds + ML_KT0 + bf * ML_KTB; LAS unsigned char* sVT = lds + ML_VT0 + bf * ML_VTB; LAS unsigned char* sSC = lds + ML_SC0 + bf * ML_SCB;
        if (c + 1 < A_NC) ML_LOAD(c + 1);
        { const int si = w & 3, tp = w >> 2;
          f32x4 sacc[2] = {(f32x4){0.f, 0.f, 0.f, 0.f}, (f32x4){0.f, 0.f, 0.f, 0.f}};
#pragma unroll
          for (int ks = 0; ks < 4; ++ks) { const bf16x8 a = *(const LAS bf16x8*)(sK + (16 * si + l15) * ML_QS + (32 * ks + 8 * g) * 2);
#pragma unroll
              for (int tt = 0; tt < 2; ++tt) { const bf16x8 bq = *(const LAS bf16x8*)(sQ + (16 * (2 * tp + tt) + l15) * ML_QS + (32 * ks + 8 * g) * 2); sacc[tt] = MFMA16(a, bq, sacc[tt]); } }
          const f32x4 u2 = *(const LAS f32x4*)(sSC + SC_U2 + (16 * si + 4 * g) * 4);
#pragma unroll
          for (int tt = 0; tt < 2; ++tt) { const int t = 16 * (2 * tp + tt) + l15; const float a2 = ((const LAS float*)(sSC + SC_A2))[t]; float e[4];
#pragma unroll
              for (int r = 0; r < 4; ++r) { const int s = 16 * si + 4 * g + r; const float x = sacc[tt][r] * __builtin_amdgcn_exp2f(a2 + u2[r]); e[r] = (s <= t) ? x : 0.f; }
              v2u pw; pw.x = pk2(e[0], e[1]); pw.y = pk2(e[2], e[3]);
              *(LAS v2u*)(lds + ML_SW + t * ML_TS + (16 * si + 4 * g) * 2) = pw; } }
        LDS_WAIT(); __syncthreads();
        if (w < 5) {
            f32x4 intra[4], inter[4];
#pragma unroll
            for (int i = 0; i < 4; ++i) { intra[i] = (f32x4){0.f, 0.f, 0.f, 0.f}; inter[i] = (f32x4){0.f, 0.f, 0.f, 0.f}; }
            const bf16x8 ones8 = (bf16x8){(short)0x3F80, (short)0x3F80, (short)0x3F80, (short)0x3F80, (short)0x3F80, (short)0x3F80, (short)0x3F80, (short)0x3F80};
            const bf16x8 zero8 = (bf16x8){0, 0, 0, 0, 0, 0, 0, 0};
            bf16x8 vraw[2];
#pragma unroll
            for (int ks = 0; ks < 2; ++ks) { vraw[ks] = *(const LAS bf16x8*)(sVT + vrow * ML_TS + (32 * ks + 8 * g) * 2);
                const bf16x8 bfrag = aux ? (l15 == 0 ? ones8 : zero8) : vraw[ks];
#pragma unroll
                for (int ti = 0; ti < 4; ++ti) { const bf16x8 af = *(const LAS bf16x8*)(lds + ML_SW + (16 * ti + l15) * ML_TS + (32 * ks + 8 * g) * 2); intra[ti] = MFMA16(af, bfrag, intra[ti]); } }
#pragma unroll
            for (int p = 0; p < 4; ++p) { v4u bw; bw.x = pk2(CT[2 * p][0], CT[2 * p][1]); bw.y = pk2(CT[2 * p][2], CT[2 * p][3]); bw.z = pk2(CT[2 * p + 1][0], CT[2 * p + 1][1]); bw.w = pk2(CT[2 * p + 1][2], CT[2 * p + 1][3]);
                const bf16x8 bfrag = __builtin_bit_cast(bf16x8, bw);
#pragma unroll
                for (int ti = 0; ti < 4; ++ti) { const v2u lo = *(const LAS v2u*)(sQ + (16 * ti + l15) * ML_QS + (32 * p + 4 * g) * 2), hi = *(const LAS v2u*)(sQ + (16 * ti + l15) * ML_QS + (32 * p + 16 + 4 * g) * 2);
                    v4u aw; aw.x = lo.x; aw.y = lo.y; aw.z = hi.x; aw.w = hi.y; inter[ti] = MFMA16(__builtin_bit_cast(bf16x8, aw), bfrag, inter[ti]); } }
#pragma unroll
            for (int ti = 0; ti < 4; ++ti) { const f32x4 dec4 = *(const LAS f32x4*)(sSC + SC_DEC + (16 * ti + 4 * g) * 4); const f32x4 nm = intra[ti] + dec4 * inter[ti];
                if (!aux) {
#pragma unroll
                    for (int r = 0; r < 4; ++r) hsnum[(size_t)(tok0 + 16 * ti + 4 * g + r) * 2048 + h * 256 + vs * 64 + vrow] = nm[r];
                } else if (l15 == 0 && vs == 0) { const f32x4 fl4 = *(const LAS f32x4*)(sSC + SC_FLOOR + (16 * ti + 4 * g) * 4);
#pragma unroll
                    for (int r = 0; r < 4; ++r) dnbuf[(size_t)(tok0 + 16 * ti + 4 * g + r) * 8 + h] = fmaxf(fabsf(nm[r]), fl4[r]); } }
            const float cdec = ((const LAS float*)(sSC + SC_CDEC))[0];
            bf16x8 bwv[2];
#pragma unroll
            for (int ks = 0; ks < 2; ++ks) { const f32x4 w0 = *(const LAS f32x4*)(sSC + SC_W + (32 * ks + 8 * g) * 4), w1 = *(const LAS f32x4*)(sSC + SC_W + (32 * ks + 8 * g + 4) * 4);
                const v4u raw = __builtin_bit_cast(v4u, vraw[ks]); v4u o;
                if (aux) { const bool on = (l15 == 0); o.x = on ? pk2(w0.x, w0.y) : 0u; o.y = on ? pk2(w0.z, w0.w) : 0u; o.z = on ? pk2(w1.x, w1.y) : 0u; o.w = on ? pk2(w1.z, w1.w) : 0u; }
                else { o.x = pk2(bflo(raw.x) * w0.x, bfhi(raw.x) * w0.y); o.y = pk2(bflo(raw.y) * w0.z, bfhi(raw.y) * w0.w); o.z = pk2(bflo(raw.z) * w1.x, bfhi(raw.z) * w1.y); o.w = pk2(bflo(raw.w) * w1.z, bfhi(raw.w) * w1.w); }
                bwv[ks] = __builtin_bit_cast(bf16x8, o); }
#pragma unroll
            for (int dt = 0; dt < 8; ++dt) { CT[dt] = CT[dt] * cdec;
#pragma unroll
                for (int ks = 0; ks < 2; ++ks) { const bf16x8 af = *(const LAS bf16x8*)(sKT + (16 * dt + l15) * ML_TS + (32 * ks + 8 * g) * 2); CT[dt] = MFMA16(af, bwv[ks], CT[dt]); } }
        } else if (w == 5) {
            if (c + 1 < A_NC) mrun = mlstm_scalars(lds + ML_SC0 + (bf ^ 1) * ML_SCB, gates, tok0 + A_L, h, lane, mrun);
        }
        if (c + 1 < A_NC) ML_STORE(bf ^ 1);
        LDS_WAIT(); __syncthreads();
    }
#undef ML_LOAD
#undef ML_STORE
}
constexpr int AT_KS = 272, AT_VS = 144, AT_KB = 17408, AT_VB = 18432, AT_K0 = 0, AT_V0 = 34816, AT_END = 71680;
__device__ __forceinline__ void attn_phase(const Frame& F, const bf16* Q, const bf16* KB, const bf16* VT, bf16* O) {
    PHASE_IDS
    LAS unsigned char* lds = F.lds;
    const int w = wave, l15 = lane & 15, g = lane >> 4;
    const int krow = tid >> 4, kc16 = tid & 15, vrow = tid >> 3, vc16 = tid & 7;
    for (int pp = blockIdx.x; pp < 512; pp += G) {
        const int bh = pp >> 3, ii = pp & 7, b = bh >> 4, h = bh & 15, tokb = b * SEQ;
        for (int half = 0; half < 2; ++half) {
            const int qb = half ? (15 - ii) : ii, t0 = 128 * qb, tq0 = t0 + 16 * w, t = tq0 + l15;
            bf16x8 qf[4];
#pragma unroll
            for (int ks = 0; ks < 4; ++ks) qf[ks] = *(const bf16x8*)(Q + (size_t)(tokb + t) * 2048 + h * 128 + 32 * ks + 8 * g);
            f32x4 OT[8];
#pragma unroll
            for (int i = 0; i < 8; ++i) OT[i] = (f32x4){0.f, 0.f, 0.f, 0.f};
            float R = 0.f;
            const int nkb = 2 * qb + 2;
            const bf16* kg = KB + (size_t)(tokb + krow) * 2048 + h * 128 + kc16 * 8;
            const bf16* vg = VT + (size_t)(h * 128 + vrow) * M + tokb + vc16 * 8;
            v4u rk[2], rv[2];
#define AT_LOAD(kb) do { const size_t _s0 = (size_t)(kb) * 64; rk[0] = *(const v4u*)(kg + _s0 * 2048); rk[1] = *(const v4u*)(kg + (_s0 + 32) * 2048); \
                rv[0] = *(const v4u*)(vg + _s0); rv[1] = *(const v4u*)(vg + (size_t)64 * M + _s0); } while (0)
#define AT_STORE(bufi) do { *(LAS v4u*)(lds + AT_K0 + (bufi) * AT_KB + krow * AT_KS + kc16 * 16) = rk[0]; *(LAS v4u*)(lds + AT_K0 + (bufi) * AT_KB + (krow + 32) * AT_KS + kc16 * 16) = rk[1]; \
                *(LAS v4u*)(lds + AT_V0 + (bufi) * AT_VB + vrow * AT_VS + vc16 * 16) = rv[0]; *(LAS v4u*)(lds + AT_V0 + (bufi) * AT_VB + (vrow + 64) * AT_VS + vc16 * 16) = rv[1]; } while (0)
            AT_LOAD(nkb - 1); AT_STORE(0);
            LDS_WAIT(); __syncthreads();
            for (int it = 0; it < nkb; ++it) {
                const int kb = nkb - 1 - it, bf = it & 1, s0 = 64 * kb;
                if (it + 1 < nkb) AT_LOAD(kb - 1);
                if (s0 <= tq0) {
                    LAS unsigned char* sK = lds + AT_K0 + bf * AT_KB; LAS unsigned char* sV = lds + AT_V0 + bf * AT_VB;
                    f32x4 z[4];
#pragma unroll
                    for (int si = 0; si < 4; ++si) { z[si] = (f32x4){0.f, 0.f, 0.f, 0.f};
#pragma unroll
                        for (int ks = 0; ks < 4; ++ks) { const bf16x8 a = *(const LAS bf16x8*)(sK + (16 * si + l15) * AT_KS + (32 * ks + 8 * g) * 2); z[si] = MFMA16(a, qf[ks], z[si]); } }
                    float L[4][4], P[4], tot[4], sufg[4];
#pragma unroll
                    for (int si = 0; si < 4; ++si) { P[si] = 0.f;
#pragma unroll
                        for (int r = 0; r < 4; ++r) { const int s = s0 + 16 * si + 4 * g + r; const float zz = z[si][r];
                            const float sp = fmaxf(zz, 0.f) + __logf(1.0f + __expf(-fabsf(zz)));
                            L[si][r] = (s < t) ? sp : 0.f; P[si] += L[si][r]; } }
#pragma unroll
                    for (int si = 0; si < 4; ++si) { const float a = __shfl_xor(P[si], 16), bb = __shfl_xor(P[si], 32), cc = __shfl_xor(P[si], 48);
                        tot[si] = P[si] + a + bb + cc; sufg[si] = (g == 0) ? (a + bb + cc) : (g == 1) ? (bb + cc) : (g == 2) ? a : 0.f; }
                    float hi = 0.f; f32x4 att[4];
#pragma unroll
                    for (int si = 3; si >= 0; --si) { float run = R + hi + sufg[si];
#pragma unroll
                        for (int r = 3; r >= 0; --r) { const int s = s0 + 16 * si + 4 * g + r; run += L[si][r]; att[si][r] = (s < t) ? __expf(z[si][r] - run) : 0.f; }
                        hi += tot[si]; }
                    R += hi;
#pragma unroll
                    for (int p = 0; p < 2; ++p) { v4u bw; bw.x = pk2(att[2 * p][0], att[2 * p][1]); bw.y = pk2(att[2 * p][2], att[2 * p][3]); bw.z = pk2(att[2 * p + 1][0], att[2 * p + 1][1]); bw.w = pk2(att[2 * p + 1][2], att[2 * p + 1][3]);
                        const bf16x8 bfrag = __builtin_bit_cast(bf16x8, bw);
#pragma unroll
                        for (int dt = 0; dt < 8; ++dt) { const v2u lo = *(const LAS v2u*)(sV + (16 * dt + l15) * AT_VS + (32 * p + 4 * g) * 2), hi2 = *(const LAS v2u*)(sV + (16 * dt + l15) * AT_VS + (32 * p + 16 + 4 * g) * 2);
                            v4u aw; aw.x = lo.x; aw.y = lo.y; aw.z = hi2.x; aw.w = hi2.y; OT[dt] = MFMA16(__builtin_bit_cast(bf16x8, aw), bfrag, OT[dt]); } }
                }
                if (it + 1 < nkb) AT_STORE(bf ^ 1);
                LDS_WAIT(); __syncthreads();
            }
#undef AT_LOAD
#undef AT_STORE
            bf16* orow = O + (size_t)(tokb + t) * 2048 + h * 128 + 4 * g;
#pragma unroll
            for (int dt = 0; dt < 8; ++dt) { v2u ow; ow.x = pk2(OT[dt][0], OT[dt][1]); ow.y = pk2(OT[dt][2], OT[dt][3]); *(v2u*)(orow + 16 * dt) = ow; }
        }
    }
}
#ifndef SKELETON
#define SKELETON 0
#endif
#define OPQ_S(x) asm volatile("" : "+s"(x))
__global__ void __launch_bounds__(NWAVES * 64, 2) fwd_kernel(Ptrs Pdummy) {
    extern __shared__ __attribute__((aligned(16))) unsigned char lds_raw[];
    KArgs kp0 = (KArgs)__builtin_amdgcn_kernarg_segment_ptr();
    Frame F;
    F.lds = (LAS unsigned char*)lds_raw;
    if (threadIdx.x < 4) ((LAS unsigned*)(F.lds + LDSCTL_OFF))[threadIdx.x] = 0u;
    __syncthreads();
    XcdBarrier bar = xcd_barrier_post((unsigned*)(kp0->ws + WS_CTL) + CW_BAR, (volatile LAS unsigned*)(F.lds + LDSCTL_OFF));
#define GRID_BAR() xcd_barrier(bar)

    p0_convert(F, kp0);
    GRID_BAR();

    for (int st = 0; st < 13; ++st) {
#define DECODE(kp_) KArgs kp_ = kp0; OPQ_S(kp_); int st_ = st; OPQ_S(st_); \
        const int sb = (st_ < 6) ? st_ : st_ - 1, l = sb / 3, ty = sb - 3 * l; (void)ty; \
        const bool is_kv = (st_ == 6), is_ffn = !is_kv && (ty != 1), is_ml = !is_kv && (ty == 1) && (l < 2), is_at = !is_kv && (ty == 1) && (l >= 2); (void)is_ffn; (void)is_ml; (void)is_at; \
        unsigned char* ws = kp_->ws; unsigned char* scr = ws + WS_SCR; (void)scr; \
        float* X = (float*)(ws + WS_X); bf16* XN = (bf16*)(ws + WS_XN); (void)X; (void)XN; \
        const float* xcur = (st_ == 0) ? kp_->in[0] : X; (void)xcur;
        int kind;
        { DECODE(kp)
          kind = is_kv ? 3 : is_ffn ? 0 : is_ml ? 1 : 2;
          const float* gain = is_kv ? kp->in[12] : ((ty == 0 ? kp->in[1] : ty == 1 ? kp->in[4] : kp->in[5]) + (size_t)l * D);
          norm_phase(F, xcur, gain, XN, is_ml, (const float*)(ws + WS_WG) + (size_t)(l & 1) * D * 16, kp->in[9] + (l & 1) * 16, (float*)(ws + WS_GATES)); }
        GRID_BAR();
        if (kind == 0) {
#if !SKELETON && !defined(NO_G1)
            { DECODE(kp)
              const int f = 2 * l + (ty == 2 ? 1 : 0);
              pg8::Gemm gm{XN, (const bf16*)(ws + WS_FFN + (size_t)f * FFN_BYTES), M, 2 * DFF, D}; pg8::StaticOrder S; S.init(M, 2 * DFF, (int)gridDim.x, (int)blockIdx.x); pg8::EpiSwiGLU E{(bf16*)(scr + SCR_ACT), DFF};
              pg8::gemm_phase<pg8::EpiSwiGLU, pg8::StaticOrder, true, true>(F.lds, gm, S, E); }
#endif
            GRID_BAR();
        } else {
#if !SKELETON && !defined(NO_GP)
            for (int ci = 0; ci < (kind == 2 ? 1 : 2); ++ci) {
                DECODE(kp)
                const unsigned char* awl = ws + WS_AW + (size_t)(l & 1) * 32 * MiB;
                const bf16 *a, *b; bf16* o; int Mx, Nx, ld, sc0; float scv = 0.08838834764831845f;
                if (ci == 0) { a = XN; Mx = M;
                    if (is_ml)      { b = (const bf16*)awl; Nx = 4096; o = (bf16*)(scr + SCR_PROJ); ld = 4096; sc0 = 1024; }
                    else if (is_at) { b = (const bf16*)(ws + WS_BQ + (size_t)(l - 2) * 8 * MiB); Nx = 2048; o = (bf16*)(scr + SCR_Q); ld = 2048; sc0 = 2048; }
                    else            { b = (const bf16*)(ws + WS_KVK); Nx = 2048; o = (bf16*)(ws + WS_KB); ld = 2048; sc0 = 0; } }
                else { b = XN; Mx = 2048; Nx = M; ld = M; sc0 = 0;
                    if (is_ml) { a = (const bf16*)(awl + 16 * MiB); o = (bf16*)(scr + SCR_VTA); }
                    else       { a = (const bf16*)(ws + WS_KVV); o = (bf16*)(ws + WS_VTB); } }
                pg8::Gemm gm{a, b, Mx, Nx, D}; pg8::StaticOrder S; S.init(Mx, Nx, (int)gridDim.x, (int)blockIdx.x);
                pg8::EpiBf16 E{o, ld, sc0, scv};
                pg8::gemm_phase<pg8::EpiBf16, pg8::StaticOrder, true, true>(F.lds, gm, S, E);
            }
#endif
            GRID_BAR();
            if (kind == 3) continue;
            if (kind == 1) {
#if !SKELETON && !defined(NO_ML)
                { DECODE(kp)
                  mlstm_phase(F, (const bf16*)(scr + SCR_PROJ), (const bf16*)(scr + SCR_VTA), (const float*)(ws + WS_GATES), (float*)(scr + SCR_HSNUM), (float*)(ws + WS_DN)); }
#endif
                GRID_BAR();
#if !SKELETON
                { DECODE(kp)
                  mlstm_finalize_phase(F, (const float*)(scr + SCR_HSNUM), (const float*)(ws + WS_DN), (const bf16*)(scr + SCR_PROJ), kp->in[10] + (size_t)l * 2048, (bf16*)(scr + SCR_HS)); }
#endif
                GRID_BAR();
            } else {
#if !SKELETON && !defined(NO_AT)
                { DECODE(kp)
                  attn_phase(F, (const bf16*)(scr + SCR_Q), (const bf16*)(ws + WS_KB), (const bf16*)(ws + WS_VTB), (bf16*)(scr + SCR_O)); }
#endif
                GRID_BAR();
            }
        }
        { DECODE(kp)
#if !SKELETON && !defined(NO_GR)
          const unsigned char* awl = ws + WS_AW + (size_t)(l & 1) * 32 * MiB;
          const int f = 2 * l + (ty == 2 ? 1 : 0);
          const bf16* rA = is_ffn ? (const bf16*)(scr + SCR_ACT) : is_ml ? (const bf16*)(scr + SCR_HS) : (const bf16*)(scr + SCR_O);
          const bf16* rB = is_ffn ? (const bf16*)(ws + WS_FFN + (size_t)f * FFN_BYTES + W1_BYTES) : is_ml ? (const bf16*)(awl + 24 * MiB) : (const bf16*)(ws + WS_BO + (size_t)(l - 2) * 8 * MiB);
          pg8::Gemm gm{rA, rB, M, D, is_ffn ? DFF : D}; pg8::StaticOrder S; S.init(M, D, (int)gridDim.x, (int)blockIdx.x); pg8::EpiRes E{xcur, X, D, is_ffn ? 0.5f : 1.0f};
          pg8::gemm_phase<pg8::EpiRes, pg8::StaticOrder, true, true>(F.lds, gm, S, E);
#else
          PHASE_IDS
          const int gw = vcu * NWAVES + wave, NGW = G * NWAVES;
          for (int m = gw; m < M; m += NGW) { const f32x4* xr = (const f32x4*)(xcur + (size_t)m * D) + lane; f32x4* xo = (f32x4*)(X + (size_t)m * D) + lane;
              for (int j = 0; j < 8; ++j) xo[64 * j] = xr[64 * j]; }
#endif
        }
        GRID_BAR();
    }
    { KArgs kp = kp0; OPQ_S(kp); final_norm_phase(F, (const float*)(kp->ws + WS_X), kp->in[16], kp->out); }
}

extern "C" void kernel_launch(void* const* d_in, const int* in_sizes, int n_in, void* d_out, int out_size, void* d_ws, size_t ws_size, hipStream_t stream) {
    static int grid = 0;
    if (grid == 0) {
        if (n_in != 17 || in_sizes[0] != M * D || out_size != M * D || ws_size < WS_END) {
            fprintf(stderr, "kernel_launch: built for 17 inputs, x/out of %d floats, >= %zu bytes of workspace; got n_in %d, in0 %d, out %d, ws %zu; nothing launched\n", M * D, (size_t)WS_END, n_in, n_in > 0 ? in_sizes[0] : -1, out_size, ws_size);
            grid = -1; return; }
        int dev = 0, cus = 0, per_cu = 0;
        if (hipGetDevice(&dev) != hipSuccess || hipDeviceGetAttribute(&cus, hipDeviceAttributeMultiprocessorCount, dev) != hipSuccess) { fprintf(stderr, "kernel_launch: device query failed\n"); grid = -1; return; }
        if (hipFuncSetAttribute((const void*)fwd_kernel, hipFuncAttributeMaxDynamicSharedMemorySize, LDS_BYTES) != hipSuccess) { fprintf(stderr, "kernel_launch: hipFuncSetAttribute failed\n"); grid = -1; return; }
        if (hipOccupancyMaxActiveBlocksPerMultiprocessor(&per_cu, (const void*)fwd_kernel, NWAVES * 64, LDS_BYTES) != hipSuccess || per_cu < 1)
            fprintf(stderr, "kernel_launch: note: occupancy query reports %d workgroups per CU\n", per_cu);
        (void)hipGetLastError();
        grid = cus;
    }
    if (grid < 0) return;
    if (hipMemsetAsync((char*)d_ws + WS_CTL, 0, CTL_BYTES, stream) != hipSuccess) { fprintf(stderr, "kernel_launch: memset failed\n"); return; }
    Ptrs p{};
    for (int i = 0; i < 17; ++i) p.in[i] = (const float*)d_in[i];
    p.out = (float*)d_out; p.ws = (unsigned char*)d_ws;
    hipLaunchKernelGGL(fwd_kernel, dim3(grid), dim3(NWAVES * 64), LDS_BYTES, stream, p);
    const hipError_t le = hipPeekAtLastError();
    if (le != hipSuccess) fprintf(stderr, "kernel_launch: launch failed: %s (grid %d)\n", hipGetErrorName(le), grid);
}
```

```cpp
#include <hip/hip_runtime.h>
#include <cstdio>
#include <cstdint>
namespace pg8 {
#define PG8_LAS __attribute__((address_space(3)))
typedef unsigned short bf16_t;
typedef short bf16x8 __attribute__((ext_vector_type(8)));
typedef float f32x4 __attribute__((ext_vector_type(4)));
typedef unsigned u32x4 __attribute__((ext_vector_type(4)));
constexpr int BM = 256, BK = 64, HALF = 128, HTB = HALF * BK * 2  , STAGE_BYTES = 8 * HTB, NXCD = 8, WGM = 8;

__host__ __device__ __forceinline__ int lds_byte(int r, int c) { const int st = (r >> 4) * 2 + (c >> 5), rr = r & 15, cc = c & 31, ob = rr * 64 + cc * 2; return st * 1024 + (ob ^ (((ob >> 9) & 1) << 5)); }
__host__ __device__ __forceinline__ void stage_rc(int b, int& R, int& C) { const int st = b / 1024, sb = b % 1024, swz = sb ^ (((sb >> 9) & 1) << 5); R = (st >> 1) * 16 + swz / 64; C = (st & 1) * 32 + (swz % 64) / 2; }
__host__ __device__ __forceinline__ int perm32(int rho) { const int n = rho >> 4, i = rho & 15; return 8 * (i >> 2) + 4 * n + (i & 3); }

struct Unit { int pm, pn; };
struct Gemm { const bf16_t* A; const bf16_t* Bt; int M, N, K; };

struct StaticOrder {
    int nM, nN, nwg, G, c;
    __host__ __device__ void init(int M, int N, int G_, int c_) { nM = M / BM; nN = N / BM; nwg = nM * nN; G = G_; c = c_; }
    __host__ __device__ bool next(int i, Unit& u) const {
        const long L = (long)i * G + c; if (L >= nwg) return false;
        int wgid = (int)L; { const int q = nwg / NXCD, r = nwg % NXCD, xcd = wgid % NXCD, off = wgid / NXCD; wgid = (xcd < r ? xcd * (q + 1) : r * (q + 1) + (xcd - r) * q) + off; }
        const int nig = WGM * nN, gid = wgid / nig, fm = gid * WGM, gsz = (nM - fm) < WGM ? (nM - fm) : WGM;
        u.pm = fm + ((wgid % nig) % gsz); u.pn = (wgid % nig) / gsz; return true;
    }
    __device__ __forceinline__ void a_ready(const Unit&) const {}
    __device__ __forceinline__ void done(const Unit&) const {}
};
__device__ __forceinline__ unsigned cvt_pk_bf16(float lo, float hi) { unsigned r; asm volatile("v_cvt_pk_bf16_f32 %0, %1, %2" : "=v"(r) : "v"(lo), "v"(hi)); return r; }
struct EpiBf16 {
    static constexpr bool PERM = true, AFTER_DRAIN = false;
    bf16_t* O; int ldc; int scale_cols; float sc;
    __device__ __forceinline__ void operator()(const f32x4 (&acc)[2][2][4][2], const Unit& u, int wr, int wc, int fr, int fq) const {
        const int row0 = u.pm * BM + wr * 64 + fr, col0 = u.pn * BM + wc * 32 + 8 * fq;
        const float s = (u.pn * BM < scale_cols) ? sc : 1.0f;
#pragma unroll
        for (int ai = 0; ai < 2; ++ai)
#pragma unroll
            for (int m = 0; m < 4; ++m) { bf16_t* rowp = O + (size_t)(row0 + ai * HALF + m * 16) * ldc + col0;
#pragma unroll
                for (int bj = 0; bj < 2; ++bj) { const f32x4 v0 = acc[ai][bj][m][0] * s, v1 = acc[ai][bj][m][1] * s;
                    u32x4 w; w.x = cvt_pk_bf16(v0[0], v0[1]); w.y = cvt_pk_bf16(v0[2], v0[3]); w.z = cvt_pk_bf16(v1[0], v1[1]); w.w = cvt_pk_bf16(v1[2], v1[3]);
                    *(u32x4*)(rowp + bj * HALF) = w; } }
    }
};
__device__ __forceinline__ float silu_mul(float g, float up) { return g * up * __builtin_amdgcn_rcpf(1.0f + __builtin_amdgcn_exp2f(-1.4426950408889634f * g)); }
struct EpiSwiGLU {
    static constexpr bool PERM = true, AFTER_DRAIN = false;
    bf16_t* O; int ldc;
    __device__ __forceinline__ void operator()(const f32x4 (&acc)[2][2][4][2], const Unit& u, int wr, int wc, int fr, int fq) const {
        const int row0 = u.pm * BM + wr * 64 + fr, col0 = u.pn * HALF + wc * 32 + 8 * fq;
#pragma unroll
        for (int ai = 0; ai < 2; ++ai)
#pragma unroll
            for (int m = 0; m < 4; ++m) { bf16_t* rowp = O + (size_t)(row0 + ai * HALF + m * 16) * ldc + col0;
                const f32x4 g0 = acc[ai][0][m][0], g1 = acc[ai][0][m][1], u0 = acc[ai][1][m][0], u1 = acc[ai][1][m][1];
                u32x4 w; w.x = cvt_pk_bf16(silu_mul(g0[0], u0[0]), silu_mul(g0[1], u0[1])); w.y = cvt_pk_bf16(silu_mul(g0[2], u0[2]), silu_mul(g0[3], u0[3]));
                w.z = cvt_pk_bf16(silu_mul(g1[0], u1[0]), silu_mul(g1[1], u1[1])); w.w = cvt_pk_bf16(silu_mul(g1[2], u1[2]), silu_mul(g1[3], u1[3]));
                *(u32x4*)rowp = w; }
    }
};
struct EpiRes {
    static constexpr bool PERM = false, AFTER_DRAIN = false;
    const float* base; float* out; int ldc; float sc;
    __device__ __forceinline__ void operator()(const f32x4 (&acc)[2][2][4][2], const Unit& u, int wr, int wc, int fr, int fq) const {
        const int row0 = u.pm * BM + wr * 64 + fr, col0 = u.pn * BM + wc * 32 + 4 * fq;
#pragma unroll
        for (int ai = 0; ai < 2; ++ai)
#pragma unroll
            for (int m = 0; m < 4; ++m) { const size_t off = (size_t)(row0 + ai * HALF + m * 16) * ldc + col0;
#pragma unroll
                for (int bj = 0; bj < 2; ++bj)
#pragma unroll
                    for (int n = 0; n < 2; ++n) { const f32x4 bs = *(const f32x4*)(base + off + bj * HALF + n * 16); *(f32x4*)(out + off + bj * HALF + n * 16) = bs + acc[ai][bj][m][n] * sc; }
                asm volatile("" ::: "memory"); }
    }
};
template <class Epi, class Sched, bool ALIGN_EPI = false, bool SP2 = false>
__device__ __forceinline__ void gemm_phase(PG8_LAS unsigned char* lds, const Gemm g, const Sched& S, const Epi& E) {
    int tid_ = threadIdx.x; asm volatile("" : "+v"(tid_));
    const int tid = tid_, wid = __builtin_amdgcn_readfirstlane(tid >> 6), lane = tid & 63, wr = wid >> 2, wc = wid & 3, fr = lane & 15, fq = lane >> 4;
    const int K = g.K, nt = K / BK;
    unsigned voffA[2], voffB[2];
#pragma unroll
    for (int i = 0; i < 2; ++i) { int R, C; stage_rc(tid * 16 + i * 8192, R, C); const int Rb = Epi::PERM ? ((R & ~31) + perm32(R & 31)) : R;
        voffA[i] = (unsigned)(R * K + C) * 2u; voffB[i] = (unsigned)(Rb * K + C) * 2u; }
    const size_t kstep = (size_t)(BK * 2);
    const size_t hstep = (size_t)HALF * K * 2;
    const size_t tstep = 2 * hstep;
    const unsigned ldsw = (unsigned)wid * 1024u;
    const int aoff = lds_byte(wr * 64 + fr, fq * 8), boff = lds_byte(wc * 32 + fr, fq * 8);
#define PG8_SA(b, h) (((b) * 2 + (h)) * HTB)
#define PG8_SB(b, h) ((4 + (b) * 2 + (h)) * HTB)
#define PG8_STAGE(bufoff, gbase, voff) do { _Pragma("unroll") for (int _i = 0; _i < 2; ++_i) \
        __builtin_amdgcn_global_load_lds((const unsigned*)((const char*)(gbase) + (voff)[_i]), (PG8_LAS unsigned*)(lds + (bufoff) + ldsw + _i * 8192), 16, 0, 0); } while (0)
#define PG8_LDA(dst, b, h) do { _Pragma("unroll") for (int m = 0; m < 4; ++m) _Pragma("unroll") for (int k = 0; k < 2; ++k) dst[m][k] = *(const PG8_LAS bf16x8*)(lds + PG8_SA(b, h) + aoff + m * 2048 + k * 1024); } while (0)
#define PG8_LDB(dst, b, h) do { _Pragma("unroll") for (int n = 0; n < 2; ++n) _Pragma("unroll") for (int k = 0; k < 2; ++k) dst[n][k] = *(const PG8_LAS bf16x8*)(lds + PG8_SB(b, h) + boff + n * 2048 + k * 1024); } while (0)
#define PG8_MMA(ai, bj, At, Bt) do { __builtin_amdgcn_s_setprio(1); _Pragma("unroll") for (int m = 0; m < 4; ++m) _Pragma("unroll") for (int n = 0; n < 2; ++n) _Pragma("unroll") for (int k = 0; k < 2; ++k) \
        acc[ai][bj][m][n] = __builtin_amdgcn_mfma_f32_16x16x32_bf16(Bt[n][k], At[m][k], acc[ai][bj][m][n], 0, 0, 0); __builtin_amdgcn_s_setprio(0); } while (0)
#define PG8_WAIT_V(n) asm volatile("s_waitcnt vmcnt(" #n ")" ::: "memory")
#define PG8_WAIT_L(n) asm volatile("s_waitcnt lgkmcnt(" #n ")" ::: "memory")
#define PG8_BAR __builtin_amdgcn_s_barrier()
#define PG8_SCHED __builtin_amdgcn_sched_barrier(0)
    Unit cur, nxt; int ui = 0;
    if (!S.next(0, cur)) return;
    f32x4 acc[2][2][4][2];
#pragma unroll
    for (int a = 0; a < 2; ++a)
#pragma unroll
        for (int b = 0; b < 2; ++b)
#pragma unroll
            for (int m = 0; m < 4; ++m)
#pragma unroll
                for (int n = 0; n < 2; ++n) acc[a][b][m][n] = (f32x4){0.f, 0.f, 0.f, 0.f};
    bf16x8 At[4][2], B0[2][2], B1[2][2];
    const char* cA = (const char*)g.A + (size_t)cur.pm * tstep; const char* cB = (const char*)g.Bt + (size_t)cur.pn * tstep;
    S.a_ready(cur);
    if constexpr (SP2) {
        PG8_STAGE(PG8_SB(0, 0), cB, voffB); PG8_STAGE(PG8_SB(0, 1), cB + hstep, voffB); PG8_STAGE(PG8_SA(0, 0), cA, voffA); PG8_STAGE(PG8_SA(0, 1), cA + hstep, voffA);
        if (wr == 1) PG8_BAR;
        PG8_WAIT_V(2); PG8_BAR;
        PG8_STAGE(PG8_SB(1, 0), cB + kstep, voffB); PG8_STAGE(PG8_SA(1, 0), cA + kstep, voffA); PG8_STAGE(PG8_SB(1, 1), cB + hstep + kstep, voffB);
        PG8_WAIT_V(6); PG8_BAR;
    } else {
        PG8_STAGE(PG8_SB(0, 0), cB, voffB); PG8_STAGE(PG8_SA(0, 0), cA, voffA); PG8_STAGE(PG8_SB(0, 1), cB + hstep, voffB); PG8_STAGE(PG8_SA(0, 1), cA + hstep, voffA);
        if (wr == 1) PG8_BAR;
        PG8_WAIT_V(4); PG8_BAR;
        PG8_STAGE(PG8_SB(1, 0), cB + kstep, voffB); PG8_STAGE(PG8_SA(1, 0), cA + kstep, voffA); PG8_STAGE(PG8_SB(1, 1), cB + hstep + kstep, voffB);
        PG8_WAIT_V(6); PG8_BAR;
    }
    for (;;) {
        const bool has_next = S.next(ui + 1, nxt);
        const char* nA = has_next ? (const char*)g.A + (size_t)nxt.pm * tstep : cA; const char* nB = has_next ? (const char*)g.Bt + (size_t)nxt.pn * tstep : cB;
        for (int t = 0; t < nt; t += 2) {
            const bool last = (t == nt - 2);
            const char* a1 = cA + (size_t)(t + 1) * kstep;
            const char* a2 = last ? nA : cA + (size_t)(t + 2) * kstep; const char* b2 = last ? nB : cB + (size_t)(t + 2) * kstep;
            const char* a3 = a2 + kstep; const char* b3 = b2 + kstep;
            if (last && has_next) S.a_ready(nxt);
            if constexpr (SP2) {
            PG8_LDB(B0, 0, 0); PG8_LDB(B1, 0, 1); PG8_SCHED; PG8_LDA(At, 0, 0); PG8_STAGE(PG8_SA(1, 1), a1 + hstep, voffA);
            PG8_WAIT_V(8); PG8_WAIT_L(0); PG8_BAR; PG8_MMA(0, 0, At, B0); PG8_MMA(0, 1, At, B1); PG8_BAR; PG8_SCHED;
            PG8_LDA(At, 0, 1); PG8_STAGE(PG8_SB(0, 0), b2, voffB); PG8_STAGE(PG8_SB(0, 1), b2 + hstep, voffB); PG8_STAGE(PG8_SA(0, 0), a2, voffA);
            PG8_WAIT_V(8); PG8_WAIT_L(0); PG8_BAR; PG8_MMA(1, 0, At, B0); PG8_MMA(1, 1, At, B1); PG8_BAR; PG8_SCHED;
            PG8_LDB(B0, 1, 0); PG8_LDB(B1, 1, 1); PG8_SCHED; PG8_LDA(At, 1, 0); PG8_STAGE(PG8_SA(0, 1), a2 + hstep, voffA);
            PG8_WAIT_V(8); PG8_WAIT_L(0); PG8_BAR; PG8_MMA(0, 0, At, B0); PG8_MMA(0, 1, At, B1); PG8_BAR; PG8_SCHED;
            PG8_LDA(At, 1, 1); PG8_STAGE(PG8_SB(1, 0), b3, voffB); PG8_STAGE(PG8_SB(1, 1), b3 + hstep, voffB); PG8_STAGE(PG8_SA(1, 0), a3, voffA);
            PG8_WAIT_V(8); PG8_WAIT_L(0); PG8_BAR; PG8_MMA(1, 0, At, B0); PG8_MMA(1, 1, At, B1); PG8_BAR; PG8_SCHED;
            } else {
            PG8_LDB(B0, 0, 0); PG8_SCHED; PG8_LDA(At, 0, 0); PG8_STAGE(PG8_SA(1, 1), a1 + hstep, voffA);
            PG8_WAIT_L(8); PG8_BAR; PG8_WAIT_L(0); PG8_MMA(0, 0, At, B0); PG8_BAR; PG8_SCHED;
            PG8_LDB(B1, 0, 1); PG8_STAGE(PG8_SB(0, 0), b2, voffB);
            PG8_BAR; PG8_WAIT_L(0); PG8_MMA(0, 1, At, B1); PG8_BAR;
            PG8_LDA(At, 0, 1); PG8_STAGE(PG8_SA(0, 0), a2, voffA);
            PG8_BAR; PG8_WAIT_L(0); PG8_MMA(1, 0, At, B0); PG8_BAR; PG8_SCHED;
            PG8_STAGE(PG8_SB(0, 1), b2 + hstep, voffB);
            PG8_WAIT_V(6); PG8_BAR; PG8_MMA(1, 1, At, B1); PG8_BAR;
            PG8_LDB(B0, 1, 0); PG8_SCHED; PG8_LDA(At, 1, 0); PG8_STAGE(PG8_SA(0, 1), a2 + hstep, voffA);
            PG8_WAIT_L(8); PG8_BAR; PG8_WAIT_L(0); PG8_MMA(0, 0, At, B0); PG8_BAR; PG8_SCHED;
            PG8_LDB(B1, 1, 1); PG8_STAGE(PG8_SB(1, 0), b3, voffB);
            PG8_BAR; PG8_WAIT_L(0); PG8_MMA(0, 1, At, B1); PG8_BAR;
            PG8_LDA(At, 1, 1); PG8_STAGE(PG8_SA(1, 0), a3, voffA);
            PG8_BAR; PG8_WAIT_L(0); PG8_MMA(1, 0, At, B0); PG8_BAR; PG8_SCHED;
            PG8_STAGE(PG8_SB(1, 1), b3 + hstep, voffB);
            PG8_WAIT_V(6); PG8_BAR; PG8_MMA(1, 1, At, B1); PG8_BAR;
            }
        }
        if constexpr (ALIGN_EPI) { if (wr == 0) PG8_BAR; }
        if constexpr (!Epi::AFTER_DRAIN) { E(acc, cur, wr, wc, fr, fq); S.done(cur); }
        if (!has_next) break;
#pragma unroll
        for (int a = 0; a < 2; ++a)
#pragma unroll
            for (int b = 0; b < 2; ++b)
#pragma unroll
                for (int m = 0; m < 4; ++m)
#pragma unroll
                    for (int n = 0; n < 2; ++n) acc[a][b][m][n] = (f32x4){0.f, 0.f, 0.f, 0.f};
        cur = nxt; cA = nA; cB = nB; ++ui;
        if constexpr (ALIGN_EPI) { if (wr == 1) PG8_BAR; }
    }
    PG8_WAIT_V(0);
    if constexpr (!ALIGN_EPI) { if (wr == 0) PG8_BAR; }
    PG8_BAR;
    if constexpr (Epi::AFTER_DRAIN) { E.fused(acc, cur, wr, wc, fr, fq, lds, wid, lane); S.done(cur); }
#undef PG8_SA
#undef PG8_SB
#undef PG8_STAGE
#undef PG8_LDA
#undef PG8_LDB
#undef PG8_MMA
#undef PG8_WAIT_V
#undef PG8_WAIT_L
#undef PG8_BAR
#undef PG8_SCHED
}
}
constexpr int D = 2048, BATCH = 4, SEQ = 2048, M = BATCH * SEQ, DFF = 5632;
constexpr int A_H = 8, A_DV = 256, A_DQK = 128, A_L = 64, A_NC = SEQ / A_L, A_INC = 6160;
constexpr int B_H = 16, B_DH = 128;
constexpr float EPS = 1e-6f, LOG2E = 1.4426950408889634f;
constexpr int NWAVES = 8;

constexpr size_t MiB = 1u << 20;
constexpr size_t WS_CTL = 0, CTL_BYTES = 1 * MiB;
constexpr size_t WS_WG = 1 * MiB;
constexpr size_t WS_GATES = 2 * MiB;
constexpr size_t WS_DN = 3 * MiB;
constexpr size_t WS_FFN = 4 * MiB;
constexpr size_t W1_BYTES = 44 * MiB, FFN_BYTES = 66 * MiB;
constexpr size_t WS_AW = WS_FFN + 8 * FFN_BYTES;
constexpr size_t WS_KVK = WS_AW + 64 * MiB, WS_KVV = WS_KVK + 8 * MiB;
constexpr size_t WS_BQ = WS_KVV + 8 * MiB, WS_BO = WS_BQ + 16 * MiB;
constexpr size_t WS_X = WS_BO + 16 * MiB;
constexpr size_t WS_XN = WS_X + 64 * MiB;
constexpr size_t WS_KB = WS_XN + 32 * MiB;
constexpr size_t WS_VTB = WS_KB + 32 * MiB;
constexpr size_t WS_SCR = WS_VTB + 32 * MiB;
constexpr size_t SCR_ACT = 0;
constexpr size_t SCR_PROJ = 0, SCR_VTA = 64 * MiB, SCR_HSNUM = 96 * MiB, SCR_HS = 160 * MiB;
constexpr size_t SCR_Q = 0, SCR_O = 32 * MiB;
constexpr size_t WS_END = WS_SCR + 256 * MiB;
constexpr int CW_BAR = 4096;

constexpr int LDS_BYTES = 147456;
constexpr int LDSCTL_OFF = 143360;
constexpr int P0_JOBS_OFF = 131072;

#define GAS __attribute__((address_space(1)))
#define LAS __attribute__((address_space(3)))
typedef unsigned short bf16;
typedef unsigned v4u __attribute__((ext_vector_type(4)));
typedef unsigned v2u __attribute__((ext_vector_type(2)));
typedef float f32x4 __attribute__((ext_vector_type(4)));
typedef float f32x2 __attribute__((ext_vector_type(2)));
typedef short bf16x8 __attribute__((ext_vector_type(8)));
typedef __bf16 nbf16x2 __attribute__((ext_vector_type(2)));
#define LDS_WAIT() asm volatile("s_waitcnt lgkmcnt(0)" ::: "memory")
#define MFMA16(a, b, c) __builtin_amdgcn_mfma_f32_16x16x32_bf16((a), (b), (c), 0, 0, 0)
__device__ __forceinline__ unsigned pk2(float lo, float hi) { f32x2 v = {lo, hi}; return __builtin_bit_cast(unsigned, __builtin_convertvector(v, nbf16x2)); }
__device__ __forceinline__ float bflo(unsigned w) { return __builtin_bit_cast(float, w << 16); }
__device__ __forceinline__ float bfhi(unsigned w) { return __builtin_bit_cast(float, w & 0xffff0000u); }
__device__ __forceinline__ float wave_sum(float v) {
#pragma unroll
    for (int o = 1; o < 64; o <<= 1) v += __shfl_xor(v, o);
    return v;
}
#define PHASE_IDS int tid = threadIdx.x; asm volatile("" : "+v"(tid)); const int lane = tid & 63, wave = __builtin_amdgcn_readfirstlane(tid >> 6); \
    const int G = gridDim.x, vcu = (G % 8 == 0) ? ((int)blockIdx.x % 8) * (G / 8) + (int)blockIdx.x / 8 : (int)blockIdx.x; (void)lane; (void)wave; (void)vcu; (void)G;
#define XB_TMO      128
#define XB_XCNT(j)  (256  + 64 * (j))
#define XB_XSUB(j)  (1280 + 64 * (j))
#define XB_XGEN(j)  (2304 + 64 * (j))
#define XB_TOP      3328
#define XB_TOPGEN   3392
#define XCD_BAR_WORDS 3456
#define XB_SPIN_CAP (1u << 18)
#define LAS __attribute__((address_space(3)))

__device__ __forceinline__ unsigned xb_ld(unsigned* p)              { return __hip_atomic_load(p, __ATOMIC_RELAXED, __HIP_MEMORY_SCOPE_AGENT); }
__device__ __forceinline__ unsigned xb_add(unsigned* p, unsigned v) { return __hip_atomic_fetch_add(p, v, __ATOMIC_RELAXED, __HIP_MEMORY_SCOPE_AGENT); }
__device__ __forceinline__ unsigned xb_xcc_id() { return (unsigned)__builtin_amdgcn_s_getreg((3 << 11) | 20) & 0xFu; }
#define XB_SPIN(cond, bar) do { unsigned _sp = 0; while (cond) { __builtin_amdgcn_s_sleep(1); \
    if ((++_sp & 255u) == 0u) { if (xb_ld(&(bar)[XB_TMO])) break; if (_sp > XB_SPIN_CAP) { atomicAdd(&(bar)[XB_TMO], 1u); break; } } } } while (0)

struct XcdBarrier {
    unsigned* bar; unsigned x;
    volatile LAS unsigned* st;
};

__device__ __forceinline__ XcdBarrier xcd_barrier_post(unsigned* bar, volatile LAS unsigned* st) {
    XcdBarrier b; b.bar = bar; b.x = xb_xcc_id(); b.st = st;
    if (threadIdx.x == 0) (void)xb_add(&bar[XB_XCNT(b.x)], 1u);
    return b;
}
__device__ __forceinline__ void xcd_barrier_complete(unsigned* bar, unsigned x, unsigned& nloc, unsigned& nx) {
    const unsigned G = gridDim.x * gridDim.y * gridDim.z;
    unsigned sum, cnt, mine, sp = 0u;
    for (;;) {
        sum = 0u; cnt = 0u; mine = 0u;
#pragma unroll
        for (unsigned j = 0; j < 16; ++j) { const unsigned c = xb_ld(&bar[XB_XCNT(j)]); sum += c; cnt += (c > 0u) ? 1u : 0u; mine = (j == x) ? c : mine; }
        if (sum == G) break;
        __builtin_amdgcn_s_sleep(1);
        if ((++sp & 255u) == 0u) { if (xb_ld(&bar[XB_TMO])) break; if (sp > XB_SPIN_CAP) { atomicAdd(&bar[XB_TMO], 1u); break; } }
    }
    nloc = mine > 0u ? mine : 1u; nx = cnt > 0u ? cnt : 1u;
}

__device__ __forceinline__ void xcd_barrier(const XcdBarrier& b) {
    asm volatile("s_waitcnt vmcnt(0)" ::: "memory");
    __syncthreads();
    if (threadIdx.x == 0) {
        unsigned* bar = b.bar;
        __builtin_amdgcn_s_waitcnt(0);
        unsigned nloc = b.st[0], nx = b.st[1];
        if (nloc == 0u) { xcd_barrier_complete(bar, b.x, nloc, nx); b.st[0] = nloc; b.st[1] = nx; }
        const unsigned old = xb_add(&bar[XB_XSUB(b.x)], 1u);
        const unsigned gen = old / nloc;
        if (old + 1u == (gen + 1u) * nloc) {
            __builtin_amdgcn_fence(__ATOMIC_RELEASE, "agent");
            asm volatile("s_waitcnt vmcnt(0)" ::: "memory");
            const unsigned og = xb_add(&bar[XB_TOP], 1u);
            const unsigned tg = og / nx;
            if (og + 1u == (tg + 1u) * nx) xb_add(&bar[XB_TOPGEN], 1u);
            else XB_SPIN(xb_ld(&bar[XB_TOPGEN]) == tg, bar);
            __builtin_amdgcn_fence(__ATOMIC_ACQUIRE, "agent");
            xb_add(&bar[XB_XGEN(b.x)], 1u);
            asm volatile("s_waitcnt vmcnt(0)" ::: "memory");
        } else {
            XB_SPIN(xb_ld(&bar[XB_XGEN(b.x)]) == gen, bar);
            __builtin_amdgcn_fence(__ATOMIC_ACQUIRE, "agent");
            asm volatile("s_waitcnt vmcnt(0)" ::: "memory");
        }
    }
    __syncthreads();
}
struct Frame { LAS unsigned char* lds; };

struct Job { const float* src; bf16* dst; int ldw, K, c0, nblk, perm, start; };
__device__ __forceinline__ void put_job(LAS Job* J, int& nj, int& start, const float* src, bf16* dst, int ldw, int K, int c0, int ncols, int perm) {
    J[nj].src = src; J[nj].dst = dst; J[nj].ldw = ldw; J[nj].K = K; J[nj].c0 = c0; J[nj].nblk = ncols / 64; J[nj].perm = perm; J[nj].start = start;
    start += (K / 64) * (ncols / 64); ++nj;
}
struct Ptrs {
    const float* in[17]; float* out; unsigned char* ws;
};
typedef const __attribute__((address_space(4))) Ptrs* KArgs;
struct CvtItem { const float* src; bf16* dst; int ldw, K; };
__device__ __forceinline__ bool cvt_get(LAS Job* J, int nj, int total, int it, int& j, CvtItem& d) {
    if (it >= total) return false;
    while (j + 1 < nj && it >= J[j + 1].start) ++j;
    const int local = it - J[j].start, nblk = J[j].nblk, nb = local % nblk, kb = local / nblk, n0 = 64 * nb, K = J[j].K, ldw = J[j].ldw;
    int sc = n0;
    if (J[j].perm) { const int t = n0 >> 8, c = n0 & 255; sc = (c < 128) ? (128 * t + c) : (DFF + 128 * t + (c - 128)); }
    d.src = J[j].src + (size_t)(64 * kb) * ldw + J[j].c0 + sc; d.dst = J[j].dst + (size_t)n0 * K + 64 * kb; d.ldw = ldw; d.K = K;
    return true;
}
__device__ __forceinline__ void cvt_load(f32x4 (&v)[16], const CvtItem& d, int lane) {
    const float* p = d.src + (size_t)(lane >> 4) * d.ldw + 4 * (lane & 15);
#pragma unroll
    for (int i = 0; i < 16; ++i) v[i] = *(const f32x4*)(p + (size_t)(4 * i) * d.ldw);
}
__device__ __forceinline__ void cvt_proc(const f32x4 (&v)[16], const CvtItem& d, LAS float* scr, int lane) {
#pragma unroll
    for (int i = 0; i < 16; ++i) { const int k = 4 * i + (lane >> 4), pcg = (lane & 15) ^ ((k >> 3) & 7); *(LAS f32x4*)(scr + k * 64 + 4 * pcg) = v[i]; }
    LDS_WAIT();
    const int c = lane & 7;
#pragma unroll
    for (int j = 0; j < 8; ++j) { const int nrow = (lane >> 3) + 8 * j; const LAS float* s = scr + (8 * c) * 64 + 4 * ((nrow >> 2) ^ c) + (nrow & 3);
        v4u o; o.x = pk2(s[0 * 64], s[1 * 64]); o.y = pk2(s[2 * 64], s[3 * 64]); o.z = pk2(s[4 * 64], s[5 * 64]); o.w = pk2(s[6 * 64], s[7 * 64]);
        *(v4u*)(d.dst + (size_t)nrow * d.K + 8 * c) = o; }
    LDS_WAIT();
}
__device__ __forceinline__ void p0_convert(const Frame& F, KArgs Pp) {
#define P (*Pp)
    PHASE_IDS
    LAS Job* J = (LAS Job*)(F.lds + P0_JOBS_OFF);
    LAS int* JN = (LAS int*)(F.lds + P0_JOBS_OFF + 40 * 40);
    if (tid == 0) {
        int nj = 0, start = 0; unsigned char* ws = P.ws;
        for (int f = 0; f < 8; ++f) { const int l = f >> 1, which = f & 1;
            const float* win = (which ? P.in[6] : P.in[2]) + (size_t)l * D * (2 * DFF);
            const float* wout = (which ? P.in[7] : P.in[3]) + (size_t)l * DFF * D;
            put_job(J, nj, start, win, (bf16*)(ws + WS_FFN + f * FFN_BYTES), 2 * DFF, D, 0, 2 * DFF, 1);
            put_job(J, nj, start, wout, (bf16*)(ws + WS_FFN + f * FFN_BYTES + W1_BYTES), D, DFF, 0, D, 0); }
        for (int l = 0; l < 2; ++l) { const float* w = P.in[8] + (size_t)l * D * A_INC; unsigned char* base = ws + WS_AW + (size_t)l * 32 * MiB;
            put_job(J, nj, start, w, (bf16*)base, A_INC, D, 0, 2048, 0);
            put_job(J, nj, start, w, (bf16*)base + (size_t)2048 * D, A_INC, D, 4096, 2048, 0);
            put_job(J, nj, start, w, (bf16*)(base + 16 * MiB), A_INC, D, 2048, 2048, 0);
            put_job(J, nj, start, P.in[11] + (size_t)l * D * D, (bf16*)(base + 24 * MiB), D, D, 0, D, 0); }
        put_job(J, nj, start, P.in[13], (bf16*)(ws + WS_KVK), 2 * D, D, 0, D, 0);
        put_job(J, nj, start, P.in[13], (bf16*)(ws + WS_KVV), 2 * D, D, D, D, 0);
        for (int j = 0; j < 2; ++j) {
            put_job(J, nj, start, P.in[14] + (size_t)j * D * D, (bf16*)(ws + WS_BQ + (size_t)j * 8 * MiB), D, D, 0, D, 0);
            put_job(J, nj, start, P.in[15] + (size_t)j * D * D, (bf16*)(ws + WS_BO + (size_t)j * 8 * MiB), D, D, 0, D, 0); }
        JN[0] = nj; JN[1] = start;
        J[nj].start = start;
    }
    __syncthreads();
    const int nj = JN[0], total = JN[1];
    LAS float* scr = (LAS float*)(F.lds + wave * 16384);
    const int gw = vcu * NWAVES + wave, NGW = G * NWAVES;
    { int j = 0, it = gw; f32x4 va[16], vb[16]; CvtItem da, db;
      bool ha = cvt_get(J, nj, total, it, j, da); if (ha) cvt_load(va, da, lane);
      while (ha) {
          it += NGW; const bool hb = cvt_get(J, nj, total, it, j, db); if (hb) cvt_load(vb, db, lane);
          cvt_proc(va, da, scr, lane);
          if (!hb) break;
          it += NGW; ha = cvt_get(J, nj, total, it, j, da); if (ha) cvt_load(va, da, lane);
          cvt_proc(vb, db, scr, lane);
      } }
    { float* wg = (float*)(P.ws + WS_WG);
      for (int i = (vcu * NWAVES + wave) * 64 + lane; i < 2 * D * 16; i += G * NWAVES * 64) { const int l = i >> 15, k = (i >> 4) & (D - 1), jj = i & 15;
          wg[i] = P.in[8][(size_t)l * D * A_INC + (size_t)k * A_INC + 6144 + jj]; } }
    __syncthreads();
#undef P
}

__device__ __forceinline__ void norm_phase(const Frame& F, const float* xin, const float* gain, bf16* xn, bool gates, const float* wg, const float* bg, float* gout) {
    PHASE_IDS
    const int gw = vcu * NWAVES + wave, NGW = G * NWAVES;
    f32x4 gv[8];
#pragma unroll
    for (int j = 0; j < 8; ++j) gv[j] = *(const f32x4*)(gain + 256 * j + 4 * lane);
    for (int m = gw; m < M; m += NGW) {
        const f32x4* xr = (const f32x4*)(xin + (size_t)m * D) + lane;
        f32x4 v[8]; float s = 0.f;
#pragma unroll
        for (int j = 0; j < 8; ++j) { v[j] = xr[64 * j]; s += (v[j].x * v[j].x + v[j].y * v[j].y) + (v[j].z * v[j].z + v[j].w * v[j].w); }
        const float rstd = 1.0f / sqrtf(wave_sum(s) * (1.0f / D) + EPS);
        v2u* o8 = (v2u*)(xn + (size_t)m * D) + lane;
#pragma unroll
        for (int j = 0; j < 8; ++j) { v[j] = v[j] * rstd * gv[j]; v2u w; w.x = pk2(v[j].x, v[j].y); w.y = pk2(v[j].z, v[j].w); o8[64 * j] = w; }
        if (gates) {
            float acc[16];
#pragma unroll
            for (int q = 0; q < 16; ++q) acc[q] = 0.f;
#pragma unroll
            for (int j = 0; j < 8; ++j)
#pragma unroll
                for (int c = 0; c < 4; ++c) { const int k = 256 * j + 4 * lane + c; const f32x4* wp = (const f32x4*)(wg + (size_t)k * 16); const float y = v[j][c];
                    const f32x4 w0 = wp[0], w1 = wp[1], w2 = wp[2], w3 = wp[3];
                    acc[0] += y * w0.x; acc[1] += y * w0.y; acc[2] += y * w0.z; acc[3] += y * w0.w; acc[4] += y * w1.x; acc[5] += y * w1.y; acc[6] += y * w1.z; acc[7] += y * w1.w;
                    acc[8] += y * w2.x; acc[9] += y * w2.y; acc[10] += y * w2.z; acc[11] += y * w2.w; acc[12] += y * w3.x; acc[13] += y * w3.y; acc[14] += y * w3.z; acc[15] += y * w3.w; }
            float r8[8], r4[4], r2[2], r1;
            { const bool up = (lane & 32) != 0;
#pragma unroll
              for (int i = 0; i < 8; ++i) { const float keep = up ? acc[i + 8] : acc[i], send = up ? acc[i] : acc[i + 8]; r8[i] = keep + __shfl_xor(send, 32); } }
            { const bool up = (lane & 16) != 0;
#pragma unroll
              for (int i = 0; i < 4; ++i) { const float keep = up ? r8[i + 4] : r8[i], send = up ? r8[i] : r8[i + 4]; r4[i] = keep + __shfl_xor(send, 16); } }
            { const bool up = (lane & 8) != 0;
#pragma unroll
              for (int i = 0; i < 2; ++i) { const float keep = up ? r4[i + 2] : r4[i], send = up ? r4[i] : r4[i + 2]; r2[i] = keep + __shfl_xor(send, 8); } }
            { const bool up = (lane & 4) != 0; const float keep = up ? r2[1] : r2[0], send = up ? r2[0] : r2[1]; r1 = keep + __shfl_xor(send, 4); }
            r1 += __shfl_xor(r1, 1); r1 += __shfl_xor(r1, 2);
            if ((lane & 3) == 0) { const int jj = ((lane >> 5) & 1) * 8 + ((lane >> 4) & 1) * 4 + ((lane >> 3) & 1) * 2 + ((lane >> 2) & 1);
                const float gpre = r1 + bg[jj]; float val;
                if (jj < 8) val = 15.0f * tanhf(gpre * (1.0f / 15.0f));
                else val = fminf(gpre, 0.f) - log1pf(expf(-fabsf(gpre)));
                gout[(size_t)m * 16 + jj] = val; }
        }
    }
}
__device__ __forceinline__ void final_norm_phase(const Frame& F, const float* xin, const float* gain, float* out) {
    PHASE_IDS
    const int gw = vcu * NWAVES + wave, NGW = G * NWAVES;
    f32x4 gv[8];
#pragma unroll
    for (int j = 0; j < 8; ++j) gv[j] = *(const f32x4*)(gain + 256 * j + 4 * lane);
    for (int m = gw; m < M; m += NGW) {
        const f32x4* xr = (const f32x4*)(xin + (size_t)m * D) + lane;
        f32x4 v[8]; float s = 0.f;
#pragma unroll
        for (int j = 0; j < 8; ++j) { v[j] = xr[64 * j]; s += (v[j].x * v[j].x + v[j].y * v[j].y) + (v[j].z * v[j].z + v[j].w * v[j].w); }
        const float rstd = 1.0f / sqrtf(wave_sum(s) * (1.0f / D) + EPS);
        f32x4* o = (f32x4*)(out + (size_t)m * D) + lane;
#pragma unroll
        for (int j = 0; j < 8; ++j) o[64 * j] = v[j] * rstd * gv[j];
    }
}
__device__ __forceinline__ void mlstm_finalize_phase(const Frame& F, const float* num, const float* dn, const bf16* proj, const float* hgain, bf16* hs) {
    PHASE_IDS
    const int gw = vcu * NWAVES + wave, NGW = G * NWAVES;
    for (int m = gw; m < M; m += NGW) {
#pragma unroll
        for (int h = 0; h < A_H; ++h) {
            const f32x4 nv = *(const f32x4*)(num + (size_t)m * 2048 + h * 256 + 4 * lane);
            const float rd = 1.0f / dn[(size_t)m * 8 + h];
            const f32x4 hv = nv * rd;
            const float ss = wave_sum((hv.x * hv.x + hv.y * hv.y) + (hv.z * hv.z + hv.w * hv.w));
            const float r = 1.0f / sqrtf(ss * (1.0f / 256.0f) + EPS);
            const f32x4 g = *(const f32x4*)(hgain + h * 256 + 4 * lane);
            const v2u ogw = *(const v2u*)(proj + (size_t)m * 4096 + 2048 + h * 256 + 4 * lane);
            const float o0 = bflo(ogw.x), o1 = bfhi(ogw.x), o2 = bflo(ogw.y), o3 = bfhi(ogw.y);
            const float y0 = hv.x * r * g.x / (1.0f + __expf(-o0)), y1 = hv.y * r * g.y / (1.0f + __expf(-o1));
            const float y2 = hv.z * r * g.z / (1.0f + __expf(-o2)), y3 = hv.w * r * g.w / (1.0f + __expf(-o3));
            v2u w; w.x = pk2(y0, y1); w.y = pk2(y2, y3);
            *(v2u*)(hs + (size_t)m * 2048 + h * 256 + 4 * lane) = w;
        }
    }
}
constexpr int ML_QS = 272, ML_TS = 144;
constexpr int ML_Q0 = 0, ML_K0 = 34816, ML_KT0 = 69632, ML_VT0 = 106496, ML_SW = 124928, ML_SC0 = 134144, ML_END = 137216;
constexpr int ML_QB = 17408, ML_KTB = 18432, ML_VTB = 9216, ML_SCB = 1536;
constexpr int SC_A2 = 0, SC_U2 = 256, SC_DEC = 512, SC_W = 768, SC_FLOOR = 1024, SC_CDEC = 1280;
static_assert(ML_END <= LDSCTL_OFF, "mLSTM LDS map");

__device__ __forceinline__ float scan_add(float x, int lane) {
#pragma unroll
    for (int o = 1; o < 64; o <<= 1) { const float y = __shfl_up(x, o); if (lane >= o) x += y; }
    return x;
}
__device__ __forceinline__ float scan_max(float x, int lane) {
#pragma unroll
    for (int o = 1; o < 64; o <<= 1) { const float y = __shfl_up(x, o); if (lane >= o) x = fmaxf(x, y); }
    return x;
}
__device__ __forceinline__ float mlstm_scalars(LAS unsigned char* sc, const float* gates, int tok0, int h, int lane, float m) {
    const float ig = gates[(size_t)(tok0 + lane) * 16 + h], lf = gates[(size_t)(tok0 + lane) * 16 + 8 + h];
    const float b = scan_add(lf, lane);
    const float u = ig - b;
    const float pm = scan_max(u, lane);
    const float mx = fmaxf(pm, m);
    const float a63 = -__shfl(mx, 63), b63 = __shfl(b, 63);
    ((LAS float*)(sc + SC_A2))[lane] = -mx * LOG2E;
    ((LAS float*)(sc + SC_U2))[lane] = u * LOG2E;
    ((LAS float*)(sc + SC_DEC))[lane] = __expf(m - mx);
    ((LAS float*)(sc + SC_W))[lane] = __expf(u + a63);
    ((LAS float*)(sc + SC_FLOOR))[lane] = __expf(-(b + mx));
    if (lane == 0) ((LAS float*)(sc + SC_CDEC))[0] = __expf(m + a63);
    return b63 - a63;
}
__device__ __forceinline__ void mlstm_phase(const Frame& F, const bf16* proj, const bf16* vta, const float* gates, float* hsnum, float* dnbuf) {
    if (blockIdx.x >= 128) return;
    PHASE_IDS
    LAS unsigned char* lds = F.lds;
    const int w = wave, l15 = lane & 15, g = lane >> 4;
    const int unit = blockIdx.x, bh = unit >> 2, vs = unit & 3, b = bh >> 3, h = bh & 7;
    const int tokb = b * SEQ;
    const int qrow0 = tid >> 4, qc16 = tid & 15;
    const int vrow_p = tid >> 3, vc16 = tid & 7;
    const bf16* qg = proj + (size_t)(tokb + qrow0) * 4096 + h * 128 + qc16 * 8;
    const bf16* vg = vta + (size_t)(h * 256 + vs * 64 + vrow_p) * M + tokb + vc16 * 8;
    v4u rq[2], rk[2], rv;
#define ML_LOAD(c) do { const size_t _t = (size_t)(c) * A_L; \
        rq[0] = *(const v4u*)(qg + _t * 4096); rq[1] = *(const v4u*)(qg + (_t + 32) * 4096); \
        rk[0] = *(const v4u*)(qg + _t * 4096 + 1024); rk[1] = *(const v4u*)(qg + (_t + 32) * 4096 + 1024); \
        rv = *(const v4u*)(vg + _t); } while (0)
#define ML_STORE(bufi) do { \
        _Pragma("unroll") for (int _i = 0; _i < 2; ++_i) { const int _row = qrow0 + 32 * _i; \
            *(LAS v4u*)(lds + ML_Q0 + (bufi) * ML_QB + _row * ML_QS + qc16 * 16) = rq[_i]; \
            *(LAS v4u*)(lds + ML_K0 + (bufi) * ML_QB + _row * ML_QS + qc16 * 16) = rk[_i]; \
            LAS unsigned char* _kt = lds + ML_KT0 + (bufi) * ML_KTB + (qc16 * 8) * ML_TS + _row * 2; \
            *(LAS bf16*)(_kt + 0 * ML_TS) = (bf16)(rk[_i].x & 0xffffu); *(LAS bf16*)(_kt + 1 * ML_TS) = (bf16)(rk[_i].x >> 16); \
            *(LAS bf16*)(_kt + 2 * ML_TS) = (bf16)(rk[_i].y & 0xffffu); *(LAS bf16*)(_kt + 3 * ML_TS) = (bf16)(rk[_i].y >> 16); \
            *(LAS bf16*)(_kt + 4 * ML_TS) = (bf16)(rk[_i].z & 0xffffu); *(LAS bf16*)(_kt + 5 * ML_TS) = (bf16)(rk[_i].z >> 16); \
            *(LAS bf16*)(_kt + 6 * ML_TS) = (bf16)(rk[_i].w & 0xffffu); *(LAS bf16*)(_kt + 7 * ML_TS) = (bf16)(rk[_i].w >> 16); } \
        *(LAS v4u*)(lds + ML_VT0 + (bufi) * ML_VTB + vrow_p * ML_TS + vc16 * 16) = rv; } while (0)
    float mrun = 0.f;
    ML_LOAD(0); ML_STORE(0);
    if (w == 5) mrun = mlstm_scalars(lds + ML_SC0, gates, tokb, h, lane, mrun);
    f32x4 CT[8];
#pragma unroll
    for (int i = 0; i < 8; ++i) CT[i] = (f32x4){0.f, 0.f, 0.f, 0.f};
    const bool aux = (w == 4);
    const int vrow = 16 * (w & 3) + l15;
    LDS_WAIT(); __syncthreads();
    for (int c = 0; c < A_NC; ++c) {
        const int bf = c & 1, tok0 = tokb + c * A_L;
        LAS unsigned char* sQ = lds + ML_Q0 + bf * ML_QB; LAS unsigned char* sK = lds + ML_K0 + bf * ML_QB;
        LAS unsigned char* sKT = lds + ML_KT0 + bf * ML_KTB; LAS unsigned char* sVT = lds + ML_VT0 + bf * ML_VTB; LAS unsigned char* sSC = lds + ML_SC0 + bf * ML_SCB;
        if (c + 1 < A_NC) ML_LOAD(c + 1);
        { const int si = w & 3, tp = w >> 2;
          f32x4 sacc[2] = {(f32x4){0.f, 0.f, 0.f, 0.f}, (f32x4){0.f, 0.f, 0.f, 0.f}};
#pragma unroll
          for (int ks = 0; ks < 4; ++ks) { const bf16x8 a = *(const LAS bf16x8*)(sK + (16 * si + l15) * ML_QS + (32 * ks + 8 * g) * 2);
#pragma unroll
              for (int tt = 0; tt < 2; ++tt) { const bf16x8 bq = *(const LAS bf16x8*)(sQ + (16 * (2 * tp + tt) + l15) * ML_QS + (32 * ks + 8 * g) * 2); sacc[tt] = MFMA16(a, bq, sacc[tt]); } }
          const f32x4 u2 = *(const LAS f32x4*)(sSC + SC_U2 + (16 * si + 4 * g) * 4);
#pragma unroll
          for (int tt = 0; tt < 2; ++tt) { const int t = 16 * (2 * tp + tt) + l15; const float a2 = ((const LAS float*)(sSC + SC_A2))[t]; float e[4];
#pragma unroll
              for (int r = 0; r < 4; ++r) { const int s = 16 * si + 4 * g + r; const float x = sacc[tt][r] * __builtin_amdgcn_exp2f(a2 + u2[r]); e[r] = (s <= t) ? x : 0.f; }
              v2u pw; pw.x = pk2(e[0], e[1]); pw.y = pk2(e[2], e[3]);
              *(LAS v2u*)(lds + ML_SW + t * ML_TS + (16 * si + 4 * g) * 2) = pw; } }
        LDS_WAIT(); __syncthreads();
        if (w < 5) {
            f32x4 intra[4], inter[4];
#pragma unroll
            for (int i = 0; i < 4; ++i) { intra[i] = (f32x4){0.f, 0.f, 0.f, 0.f}; inter[i] = (f32x4){0.f, 0.f, 0.f, 0.f}; }
            const bf16x8 ones8 = (bf16x8){(short)0x3F80, (short)0x3F80, (short)0x3F80, (short)0x3F80, (short)0x3F80, (short)0x3F80, (short)0x3F80, (short)0x3F80};
            const bf16x8 zero8 = (bf16x8){0, 0, 0, 0, 0, 0, 0, 0};
            bf16x8 vraw[2];
#pragma unroll
            for (int ks = 0; ks < 2; ++ks) { vraw[ks] = *(const LAS bf16x8*)(sVT + vrow * ML_TS + (32 * ks + 8 * g) * 2);
                const bf16x8 bfrag = aux ? (l15 == 0 ? ones8 : zero8) : vraw[ks];
#pragma unroll
                for (int ti = 0; ti < 4; ++ti) { const bf16x8 af = *(const LAS bf16x8*)(lds + ML_SW + (16 * ti + l15) * ML_TS + (32 * ks + 8 * g) * 2); intra[ti] = MFMA16(af, bfrag, intra[ti]); } }
#pragma unroll
            for (int p = 0; p < 4; ++p) { v4u bw; bw.x = pk2(CT[2 * p][0], CT[2 * p][1]); bw.y = pk2(CT[2 * p][2], CT[2 * p][3]); bw.z = pk2(CT[2 * p + 1][0], CT[2 * p + 1][1]); bw.w = pk2(CT[2 * p + 1][2], CT[2 * p + 1][3]);
                const bf16x8 bfrag = __builtin_bit_cast(bf16x8, bw);
#pragma unroll
                for (int ti = 0; ti < 4; ++ti) { const v2u lo = *(const LAS v2u*)(sQ + (16 * ti + l15) * ML_QS + (32 * p + 4 * g) * 2), hi = *(const LAS v2u*)(sQ + (16 * ti + l15) * ML_QS + (32 * p + 16 + 4 * g) * 2);
                    v4u aw; aw.x = lo.x; aw.y = lo.y; aw.z = hi.x; aw.w = hi.y; inter[ti] = MFMA16(__builtin_bit_cast(bf16x8, aw), bfrag, inter[ti]); } }
#pragma unroll
            for (int ti = 0; ti < 4; ++ti) { const f32x4 dec4 = *(const LAS f32x4*)(sSC + SC_DEC + (16 * ti + 4 * g) * 4); const f32x4 nm = intra[ti] + dec4 * inter[ti];
                if (!aux) {
#pragma unroll
                    for (int r = 0; r < 4; ++r) hsnum[(size_t)(tok0 + 16 * ti + 4 * g + r) * 2048 + h * 256 + vs * 64 + vrow] = nm[r];
                } else if (l15 == 0 && vs == 0) { const f32x4 fl4 = *(const LAS f32x4*)(sSC + SC_FLOOR + (16 * ti + 4 * g) * 4);
#pragma unroll
                    for (int r = 0; r < 4; ++r) dnbuf[(size_t)(tok0 + 16 * ti + 4 * g + r) * 8 + h] = fmaxf(fabsf(nm[r]), fl4[r]); } }
            const float cdec = ((const LAS float*)(sSC + SC_CDEC))[0];
            bf16x8 bwv[2];
#pragma unroll
            for (int ks = 0; ks < 2; ++ks) { const f32x4 w0 = *(const LAS f32x4*)(sSC + SC_W + (32 * ks + 8 * g) * 4), w1 = *(const LAS f32x4*)(sSC + SC_W + (32 * ks + 8 * g + 4) * 4);
                const v4u raw = __builtin_bit_cast(v4u, vraw[ks]); v4u o;
                if (aux) { const bool on = (l15 == 0); o.x = on ? pk2(w0.x, w0.y) : 0u; o.y = on ? pk2(w0.z, w0.w) : 0u; o.z = on ? pk2(w1.x, w1.y) : 0u; o.w = on ? pk2(w1.z, w1.w) : 0u; }
                else { o.x = pk2(bflo(raw.x) * w0.x, bfhi(raw.x) * w0.y); o.y = pk2(bflo(raw.y) * w0.z, bfhi(raw.y) * w0.w); o.z = pk2(bflo(raw.z) * w1.x, bfhi(raw.z) * w1.y); o.w = pk2(bflo(raw.w) * w1.z, bfhi(raw.w) * w1.w); }
                bwv[ks] = __builtin_bit_cast(bf16x8, o); }
#pragma unroll
            for (int dt = 0; dt < 8; ++dt) { CT[dt] = CT[dt] * cdec;
#pragma unroll
                for (int ks = 0; ks < 2; ++ks) { const bf16x8 af = *(const LAS bf16x8*)(sKT + (16 * dt + l15) * ML_TS + (32 * ks + 8 * g) * 2); CT[dt] = MFMA16(af, bwv[ks], CT[dt]); } }
        } else if (w == 5) {
            if (c + 1 < A_NC) mrun = mlstm_scalars(lds + ML_SC0 + (bf ^ 1) * ML_SCB, gates, tok0 + A_L, h, lane, mrun);
        }
        if (c + 1 < A_NC) ML_STORE(bf ^ 1);
        LDS_WAIT(); __syncthreads();
    }
#undef ML_LOAD
#undef ML_STORE
}
constexpr int AT_KS = 272, AT_VS = 144, AT_KB = 17408, AT_VB = 18432, AT_K0 = 0, AT_V0 = 34816, AT_END = 71680;
__device__ __forceinline__ void attn_phase(const Frame& F, const bf16* Q, const bf16* KB, const bf16* VT, bf16* O) {
    PHASE_IDS
    LAS unsigned char* lds = F.lds;
    const int w = wave, l15 = lane & 15, g = lane >> 4;
    const int krow = tid >> 4, kc16 = tid & 15, vrow = tid >> 3, vc16 = tid & 7;
    for (int pp = blockIdx.x; pp < 512; pp += G) {
        const int bh = pp >> 3, ii = pp & 7, b = bh >> 4, h = bh & 15, tokb = b * SEQ;
        for (int half = 0; half < 2; ++half) {
            const int qb = half ? (15 - ii) : ii, t0 = 128 * qb, tq0 = t0 + 16 * w, t = tq0 + l15;
            bf16x8 qf[4];
#pragma unroll
            for (int ks = 0; ks < 4; ++ks) qf[ks] = *(const bf16x8*)(Q + (size_t)(tokb + t) * 2048 + h * 128 + 32 * ks + 8 * g);
            f32x4 OT[8];
#pragma unroll
            for (int i = 0; i < 8; ++i) OT[i] = (f32x4){0.f, 0.f, 0.f, 0.f};
            float R = 0.f;
            const int nkb = 2 * qb + 2;
            const bf16* kg = KB + (size_t)(tokb + krow) * 2048 + h * 128 + kc16 * 8;
            const bf16* vg = VT + (size_t)(h * 128 + vrow) * M + tokb + vc16 * 8;
            v4u rk[2], rv[2];
#define AT_LOAD(kb) do { const size_t _s0 = (size_t)(kb) * 64; rk[0] = *(const v4u*)(kg + _s0 * 2048); rk[1] = *(const v4u*)(kg + (_s0 + 32) * 2048); \
                rv[0] = *(const v4u*)(vg + _s0); rv[1] = *(const v4u*)(vg + (size_t)64 * M + _s0); } while (0)
#define AT_STORE(bufi) do { *(LAS v4u*)(lds + AT_K0 + (bufi) * AT_KB + krow * AT_KS + kc16 * 16) = rk[0]; *(LAS v4u*)(lds + AT_K0 + (bufi) * AT_KB + (krow + 32) * AT_KS + kc16 * 16) = rk[1]; \
                *(LAS v4u*)(lds + AT_V0 + (bufi) * AT_VB + vrow * AT_VS + vc16 * 16) = rv[0]; *(LAS v4u*)(lds + AT_V0 + (bufi) * AT_VB + (vrow + 64) * AT_VS + vc16 * 16) = rv[1]; } while (0)
            AT_LOAD(nkb - 1); AT_STORE(0);
            LDS_WAIT(); __syncthreads();
            for (int it = 0; it < nkb; ++it) {
                const int kb = nkb - 1 - it, bf = it & 1, s0 = 64 * kb;
                if (it + 1 < nkb) AT_LOAD(kb - 1);
                if (s0 <= tq0) {
                    LAS unsigned char* sK = lds + AT_K0 + bf * AT_KB; LAS unsigned char* sV = lds + AT_V0 + bf * AT_VB;
                    f32x4 z[4];
#pragma unroll
                    for (int si = 0; si < 4; ++si) { z[si] = (f32x4){0.f, 0.f, 0.f, 0.f};
#pragma unroll
                        for (int ks = 0; ks < 4; ++ks) { const bf16x8 a = *(const LAS bf16x8*)(sK + (16 * si + l15) * AT_KS + (32 * ks + 8 * g) * 2); z[si] = MFMA16(a, qf[ks], z[si]); } }
                    float L[4][4], P[4], tot[4], sufg[4];
#pragma unroll
                    for (int si = 0; si < 4; ++si) { P[si] = 0.f;
#pragma unroll
                        for (int r = 0; r < 4; ++r) { const int s = s0 + 16 * si + 4 * g + r; const float zz = z[si][r];
                            const float sp = fmaxf(zz, 0.f) + __logf(1.0f + __expf(-fabsf(zz)));
                            L[si][r] = (s < t) ? sp : 0.f; P[si] += L[si][r]; } }
#pragma unroll
                    for (int si = 0; si < 4; ++si) { const float a = __shfl_xor(P[si], 16), bb = __shfl_xor(P[si], 32), cc = __shfl_xor(P[si], 48);
                        tot[si] = P[si] + a + bb + cc; sufg[si] = (g == 0) ? (a + bb + cc) : (g == 1) ? (bb + cc) : (g == 2) ? a : 0.f; }
                    float hi = 0.f; f32x4 att[4];
#pragma unroll
                    for (int si = 3; si >= 0; --si) { float run = R + hi + sufg[si];
#pragma unroll
                        for (int r = 3; r >= 0; --r) { const int s = s0 + 16 * si + 4 * g + r; run += L[si][r]; att[si][r] = (s < t) ? __expf(z[si][r] - run) : 0.f; }
                        hi += tot[si]; }
                    R += hi;
#pragma unroll
                    for (int p = 0; p < 2; ++p) { v4u bw; bw.x = pk2(att[2 * p][0], att[2 * p][1]); bw.y = pk2(att[2 * p][2], att[2 * p][3]); bw.z = pk2(att[2 * p + 1][0], att[2 * p + 1][1]); bw.w = pk2(att[2 * p + 1][2], att[2 * p + 1][3]);
                        const bf16x8 bfrag = __builtin_bit_cast(bf16x8, bw);
#pragma unroll
                        for (int dt = 0; dt < 8; ++dt) { const v2u lo = *(const LAS v2u*)(sV + (16 * dt + l15) * AT_VS + (32 * p + 4 * g) * 2), hi2 = *(const LAS v2u*)(sV + (16 * dt + l15) * AT_VS + (32 * p + 16 + 4 * g) * 2);
                            v4u aw; aw.x = lo.x; aw.y = lo.y; aw.z = hi2.x; aw.w = hi2.y; OT[dt] = MFMA16(__builtin_bit_cast(bf16x8, aw), bfrag, OT[dt]); } }
                }
                if (it + 1 < nkb) AT_STORE(bf ^ 1);
                LDS_WAIT(); __syncthreads();
            }
#undef AT_LOAD
#undef AT_STORE
            bf16* orow = O + (size_t)(tokb + t) * 2048 + h * 128 + 4 * g;
#pragma unroll
            for (int dt = 0; dt < 8; ++dt) { v2u ow; ow.x = pk2(OT[dt][0], OT[dt][1]); ow.y = pk2(OT[dt][2], OT[dt][3]); *(v2u*)(orow + 16 * dt) = ow; }
        }
    }
}
#ifndef SKELETON
#define SKELETON 0
#endif
#ifndef REP_P0
#define REP_P0 1
#endif
#ifndef REP_NORM
#define REP_NORM 1
#endif
#ifndef REP_G1
#define REP_G1 1
#endif
#ifndef REP_GP
#define REP_GP 1
#endif
#ifndef REP_ML
#define REP_ML 1
#endif
#ifndef REP_AT
#define REP_AT 1
#endif
#ifndef REP_BAR
#define REP_BAR 1
#endif
#define OPQ_S(x) asm volatile("" : "+s"(x))
__global__ void __launch_bounds__(NWAVES * 64, 2) fwd_kernel(Ptrs Pdummy) {
    extern __shared__ __attribute__((aligned(16))) unsigned char lds_raw[];
    KArgs kp0 = (KArgs)__builtin_amdgcn_kernarg_segment_ptr();
    Frame F;
    F.lds = (LAS unsigned char*)lds_raw;
    if (threadIdx.x < 4) ((LAS unsigned*)(F.lds + LDSCTL_OFF))[threadIdx.x] = 0u;
    __syncthreads();
    XcdBarrier bar = xcd_barrier_post((unsigned*)(kp0->ws + WS_CTL) + CW_BAR, (volatile LAS unsigned*)(F.lds + LDSCTL_OFF));
#define GRID_BAR() do { for (int rb_ = 0; rb_ < REP_BAR; ++rb_) xcd_barrier(bar); } while (0)

    for (int rep = 0; rep < REP_P0; ++rep) p0_convert(F, kp0);
    GRID_BAR();

    for (int st = 0; st < 13; ++st) {
#define DECODE(kp_) KArgs kp_ = kp0; OPQ_S(kp_); int st_ = st; OPQ_S(st_); \
        const int sb = (st_ < 6) ? st_ : st_ - 1, l = sb / 3, ty = sb - 3 * l; (void)ty; \
        const bool is_kv = (st_ == 6), is_ffn = !is_kv && (ty != 1), is_ml = !is_kv && (ty == 1) && (l < 2), is_at = !is_kv && (ty == 1) && (l >= 2); (void)is_ffn; (void)is_ml; (void)is_at; \
        unsigned char* ws = kp_->ws; unsigned char* scr = ws + WS_SCR; (void)scr; \
        float* X = (float*)(ws + WS_X); bf16* XN = (bf16*)(ws + WS_XN); (void)X; (void)XN; \
        const float* xcur = (st_ == 0) ? kp_->in[0] : X; (void)xcur;
        int kind;
        { DECODE(kp)
          kind = is_kv ? 3 : is_ffn ? 0 : is_ml ? 1 : 2;
          const float* gain = is_kv ? kp->in[12] : ((ty == 0 ? kp->in[1] : ty == 1 ? kp->in[4] : kp->in[5]) + (size_t)l * D);
          for (int rep = 0; rep < REP_NORM; ++rep) norm_phase(F, xcur, gain, XN, is_ml, (const float*)(ws + WS_WG) + (size_t)(l & 1) * D * 16, kp->in[9] + (l & 1) * 16, (float*)(ws + WS_GATES)); }
        GRID_BAR();
        if (kind == 0) {
#if !SKELETON && !defined(NO_G1)
            { DECODE(kp)
              const int f = 2 * l + (ty == 2 ? 1 : 0);
              pg8::Gemm gm{XN, (const bf16*)(ws + WS_FFN + (size_t)f * FFN_BYTES), M, 2 * DFF, D}; pg8::StaticOrder S; S.init(M, 2 * DFF, (int)gridDim.x, (int)blockIdx.x); pg8::EpiSwiGLU E{(bf16*)(scr + SCR_ACT), DFF};
              for (int rep = 0; rep < REP_G1; ++rep) pg8::gemm_phase<pg8::EpiSwiGLU, pg8::StaticOrder, true, true>(F.lds, gm, S, E); }
#endif
            GRID_BAR();
        } else {
#if !SKELETON && !defined(NO_GP)
            for (int ci = 0; ci < (kind == 2 ? 1 : 2); ++ci) {
                DECODE(kp)
                const unsigned char* awl = ws + WS_AW + (size_t)(l & 1) * 32 * MiB;
                const bf16 *a, *b; bf16* o; int Mx, Nx, ld, sc0; float scv = 0.08838834764831845f;
                if (ci == 0) { a = XN; Mx = M;
                    if (is_ml)      { b = (const bf16*)awl; Nx = 4096; o = (bf16*)(scr + SCR_PROJ); ld = 4096; sc0 = 1024; }
                    else if (is_at) { b = (const bf16*)(ws + WS_BQ + (size_t)(l - 2) * 8 * MiB); Nx = 2048; o = (bf16*)(scr + SCR_Q); ld = 2048; sc0 = 2048; }
                    else            { b = (const bf16*)(ws + WS_KVK); Nx = 2048; o = (bf16*)(ws + WS_KB); ld = 2048; sc0 = 0; } }
                else { b = XN; Mx = 2048; Nx = M; ld = M; sc0 = 0;
                    if (is_ml) { a = (const bf16*)(awl + 16 * MiB); o = (bf16*)(scr + SCR_VTA); }
                    else       { a = (const bf16*)(ws + WS_KVV); o = (bf16*)(ws + WS_VTB); } }
                pg8::Gemm gm{a, b, Mx, Nx, D}; pg8::StaticOrder S; S.init(Mx, Nx, (int)gridDim.x, (int)blockIdx.x);
                pg8::EpiBf16 E{o, ld, sc0, scv};
                for (int rep = 0; rep < REP_GP; ++rep) pg8::gemm_phase<pg8::EpiBf16, pg8::StaticOrder, true, true>(F.lds, gm, S, E);
            }
#endif
            GRID_BAR();
            if (kind == 3) continue;
            if (kind == 1) {
#if !SKELETON && !defined(NO_ML)
                { DECODE(kp)
                  for (int rep = 0; rep < REP_ML; ++rep) mlstm_phase(F, (const bf16*)(scr + SCR_PROJ), (const bf16*)(scr + SCR_VTA), (const float*)(ws + WS_GATES), (float*)(scr + SCR_HSNUM), (float*)(ws + WS_DN)); }
#endif
                GRID_BAR();
#if !SKELETON
                { DECODE(kp)
                  mlstm_finalize_phase(F, (const float*)(scr + SCR_HSNUM), (const float*)(ws + WS_DN), (const bf16*)(scr + SCR_PROJ), kp->in[10] + (size_t)l * 2048, (bf16*)(scr + SCR_HS)); }
#endif
                GRID_BAR();
            } else {
#if !SKELETON && !defined(NO_AT)
                { DECODE(kp)
                  for (int rep = 0; rep < REP_AT; ++rep) attn_phase(F, (const bf16*)(scr + SCR_Q), (const bf16*)(ws + WS_KB), (const bf16*)(ws + WS_VTB), (bf16*)(scr + SCR_O)); }
#endif
                GRID_BAR();
            }
        }
        { DECODE(kp)
#if !SKELETON && !defined(NO_GR)
          const unsigned char* awl = ws + WS_AW + (size_t)(l & 1) * 32 * MiB;
          const int f = 2 * l + (ty == 2 ? 1 : 0);
          const bf16* rA = is_ffn ? (const bf16*)(scr + SCR_ACT) : is_ml ? (const bf16*)(scr + SCR_HS) : (const bf16*)(scr + SCR_O);
          const bf16* rB = is_ffn ? (const bf16*)(ws + WS_FFN + (size_t)f * FFN_BYTES + W1_BYTES) : is_ml ? (const bf16*)(awl + 24 * MiB) : (const bf16*)(ws + WS_BO + (size_t)(l - 2) * 8 * MiB);
          pg8::Gemm gm{rA, rB, M, D, is_ffn ? DFF : D}; pg8::StaticOrder S; S.init(M, D, (int)gridDim.x, (int)blockIdx.x); pg8::EpiRes E{xcur, X, D, is_ffn ? 0.5f : 1.0f};
          pg8::gemm_phase<pg8::EpiRes, pg8::StaticOrder, true, true>(F.lds, gm, S, E);
#else
          PHASE_IDS
          const int gw = vcu * NWAVES + wave, NGW = G * NWAVES;
          for (int m = gw; m < M; m += NGW) { const f32x4* xr = (const f32x4*)(xcur + (size_t)m * D) + lane; f32x4* xo = (f32x4*)(X + (size_t)m * D) + lane;
              for (int j = 0; j < 8; ++j) xo[64 * j] = xr[64 * j]; }
#endif
        }
        GRID_BAR();
    }
    { KArgs kp = kp0; OPQ_S(kp); final_norm_phase(F, (const float*)(kp->ws + WS_X), kp->in[16], kp->out); }
}

extern "C" void kernel_launch(void* const* d_in, const int* in_sizes, int n_in, void* d_out, int out_size, void* d_ws, size_t ws_size, hipStream_t stream) {
    static int grid = 0;
    if (grid == 0) {
        if (n_in != 17 || in_sizes[0] != M * D || out_size != M * D || ws_size < WS_END) {
            fprintf(stderr, "kernel_launch: built for 17 inputs, x/out of %d floats, >= %zu bytes of workspace; got n_in %d, in0 %d, out %d, ws %zu; nothing launched\n", M * D, (size_t)WS_END, n_in, n_in > 0 ? in_sizes[0] : -1, out_size, ws_size);
            grid = -1; return; }
        int dev = 0, cus = 0, per_cu = 0;
        if (hipGetDevice(&dev) != hipSuccess || hipDeviceGetAttribute(&cus, hipDeviceAttributeMultiprocessorCount, dev) != hipSuccess) { fprintf(stderr, "kernel_launch: device query failed\n"); grid = -1; return; }
        if (hipFuncSetAttribute((const void*)fwd_kernel, hipFuncAttributeMaxDynamicSharedMemorySize, LDS_BYTES) != hipSuccess) { fprintf(stderr, "kernel_launch: hipFuncSetAttribute failed\n"); grid = -1; return; }
        if (hipOccupancyMaxActiveBlocksPerMultiprocessor(&per_cu, (const void*)fwd_kernel, NWAVES * 64, LDS_BYTES) != hipSuccess || per_cu < 1)
            fprintf(stderr, "kernel_launch: note: occupancy query reports %d workgroups per CU\n", per_cu);
        (void)hipGetLastError();
        grid = cus;
    }
    if (grid < 0) return;
    if (hipMemsetAsync((char*)d_ws + WS_CTL, 0, CTL_BYTES, stream) != hipSuccess) { fprintf(stderr, "kernel_launch: memset failed\n"); return; }
    Ptrs p{};
    for (int i = 0; i < 17; ++i) p.in[i] = (const float*)d_in[i];
    p.out = (float*)d_out; p.ws = (unsigned char*)d_ws;
    hipLaunchKernelGGL(fwd_kernel, dim3(grid), dim3(NWAVES * 64), LDS_BYTES, stream, p);
    const hipError_t le = hipPeekAtLastError();
    if (le != hipSuccess) fprintf(stderr, "kernel_launch: launch failed: %s (grid %d)\n", hipGetErrorName(le), grid);
}
```

```cpp
#include <hip/hip_runtime.h>
#include <cstdio>
#include <cstdint>
namespace pg8 {
#define PG8_LAS __attribute__((address_space(3)))
typedef unsigned short bf16_t;
typedef short bf16x8 __attribute__((ext_vector_type(8)));
typedef float f32x4 __attribute__((ext_vector_type(4)));
typedef unsigned u32x4 __attribute__((ext_vector_type(4)));
constexpr int BM = 256, BK = 64, HALF = 128, HTB = HALF * BK * 2  , STAGE_BYTES = 8 * HTB, NXCD = 8, WGM = 8;

__host__ __device__ __forceinline__ int lds_byte(int r, int c) { const int st = (r >> 4) * 2 + (c >> 5), rr = r & 15, cc = c & 31, ob = rr * 64 + cc * 2; return st * 1024 + (ob ^ (((ob >> 9) & 1) << 5)); }
__host__ __device__ __forceinline__ void stage_rc(int b, int& R, int& C) { const int st = b / 1024, sb = b % 1024, swz = sb ^ (((sb >> 9) & 1) << 5); R = (st >> 1) * 16 + swz / 64; C = (st & 1) * 32 + (swz % 64) / 2; }
__host__ __device__ __forceinline__ int perm32(int rho) { const int n = rho >> 4, i = rho & 15; return 8 * (i >> 2) + 4 * n + (i & 3); }

struct Unit { int pm, pn; };
struct Gemm { const bf16_t* A; const bf16_t* Bt; int M, N, K; };

struct StaticOrder {
    int nM, nN, nwg, G, c;
    __host__ __device__ void init(int M, int N, int G_, int c_) { nM = M / BM; nN = N / BM; nwg = nM * nN; G = G_; c = c_; }
    __host__ __device__ bool next(int i, Unit& u) const {
        const long L = (long)i * G + c; if (L >= nwg) return false;
        int wgid = (int)L; { const int q = nwg / NXCD, r = nwg % NXCD, xcd = wgid % NXCD, off = wgid / NXCD; wgid = (xcd < r ? xcd * (q + 1) : r * (q + 1) + (xcd - r) * q) + off; }
        const int nig = WGM * nN, gid = wgid / nig, fm = gid * WGM, gsz = (nM - fm) < WGM ? (nM - fm) : WGM;
        u.pm = fm + ((wgid % nig) % gsz); u.pn = (wgid % nig) / gsz; return true;
    }
    __device__ __forceinline__ void a_ready(const Unit&) const {}
    __device__ __forceinline__ void done(const Unit&) const {}
};
__device__ __forceinline__ unsigned cvt_pk_bf16(float lo, float hi) { unsigned r; asm volatile("v_cvt_pk_bf16_f32 %0, %1, %2" : "=v"(r) : "v"(lo), "v"(hi)); return r; }
struct EpiBf16 {
    static constexpr bool PERM = true, AFTER_DRAIN = false;
    bf16_t* O; int ldc; int scale_cols; float sc;
    __device__ __forceinline__ void operator()(const f32x4 (&acc)[2][2][4][2], const Unit& u, int wr, int wc, int fr, int fq) const {
        const int row0 = u.pm * BM + wr * 64 + fr, col0 = u.pn * BM + wc * 32 + 8 * fq;
        const float s = (u.pn * BM < scale_cols) ? sc : 1.0f;
#pragma unroll
        for (int ai = 0; ai < 2; ++ai)
#pragma unroll
            for (int m = 0; m < 4; ++m) { bf16_t* rowp = O + (size_t)(row0 + ai * HALF + m * 16) * ldc + col0;
#pragma unroll
                for (int bj = 0; bj < 2; ++bj) { const f32x4 v0 = acc[ai][bj][m][0] * s, v1 = acc[ai][bj][m][1] * s;
                    u32x4 w; w.x = cvt_pk_bf16(v0[0], v0[1]); w.y = cvt_pk_bf16(v0[2], v0[3]); w.z = cvt_pk_bf16(v1[0], v1[1]); w.w = cvt_pk_bf16(v1[2], v1[3]);
                    *(u32x4*)(rowp + bj * HALF) = w; } }
    }
};
__device__ __forceinline__ float silu_mul(float g, float up) { return g * up * __builtin_amdgcn_rcpf(1.0f + __builtin_amdgcn_exp2f(-1.4426950408889634f * g)); }
struct EpiSwiGLU {
    static constexpr bool PERM = true, AFTER_DRAIN = false;
    bf16_t* O; int ldc;
    __device__ __forceinline__ void operator()(const f32x4 (&acc)[2][2][4][2], const Unit& u, int wr, int wc, int fr, int fq) const {
        const int row0 = u.pm * BM + wr * 64 + fr, col0 = u.pn * HALF + wc * 32 + 8 * fq;
#pragma unroll
        for (int ai = 0; ai < 2; ++ai)
#pragma unroll
            for (int m = 0; m < 4; ++m) { bf16_t* rowp = O + (size_t)(row0 + ai * HALF + m * 16) * ldc + col0;
                const f32x4 g0 = acc[ai][0][m][0], g1 = acc[ai][0][m][1], u0 = acc[ai][1][m][0], u1 = acc[ai][1][m][1];
                u32x4 w; w.x = cvt_pk_bf16(silu_mul(g0[0], u0[0]), silu_mul(g0[1], u0[1])); w.y = cvt_pk_bf16(silu_mul(g0[2], u0[2]), silu_mul(g0[3], u0[3]));
                w.z = cvt_pk_bf16(silu_mul(g1[0], u1[0]), silu_mul(g1[1], u1[1])); w.w = cvt_pk_bf16(silu_mul(g1[2], u1[2]), silu_mul(g1[3], u1[3]));
                *(u32x4*)rowp = w; }
    }
};
struct EpiRes {
    static constexpr bool PERM = false, AFTER_DRAIN = false;
    const float* base; float* out; int ldc; float sc;
    __device__ __forceinline__ void operator()(const f32x4 (&acc)[2][2][4][2], const Unit& u, int wr, int wc, int fr, int fq) const {
        const int row0 = u.pm * BM + wr * 64 + fr, col0 = u.pn * BM + wc * 32 + 4 * fq;
#pragma unroll
        for (int ai = 0; ai < 2; ++ai)
#pragma unroll
            for (int m = 0; m < 4; ++m) { const size_t off = (size_t)(row0 + ai * HALF + m * 16) * ldc + col0;
#pragma unroll
                for (int bj = 0; bj < 2; ++bj)
#pragma unroll
                    for (int n = 0; n < 2; ++n) { const f32x4 bs = *(const f32x4*)(base + off + bj * HALF + n * 16); *(f32x4*)(out + off + bj * HALF + n * 16) = bs + acc[ai][bj][m][n] * sc; }
                asm volatile("" ::: "memory"); }
    }
};
template <class Epi, class Sched, bool ALIGN_EPI = false, bool SP2 = false>
__device__ __forceinline__ void gemm_phase(PG8_LAS unsigned char* lds, const Gemm g, const Sched& S, const Epi& E) {
    int tid_ = threadIdx.x; asm volatile("" : "+v"(tid_));
    const int tid = tid_, wid = __builtin_amdgcn_readfirstlane(tid >> 6), lane = tid & 63, wr = wid >> 2, wc = wid & 3, fr = lane & 15, fq = lane >> 4;
    const int K = g.K, nt = K / BK;
    unsigned voffA[2], voffB[2];
#pragma unroll
    for (int i = 0; i < 2; ++i) { int R, C; stage_rc(tid * 16 + i * 8192, R, C); const int Rb = Epi::PERM ? ((R & ~31) + perm32(R & 31)) : R;
        voffA[i] = (unsigned)(R * K + C) * 2u; voffB[i] = (unsigned)(Rb * K + C) * 2u; }
    const size_t kstep = (size_t)(BK * 2);
    const size_t hstep = (size_t)HALF * K * 2;
    const size_t tstep = 2 * hstep;
    const unsigned ldsw = (unsigned)wid * 1024u;
    const int aoff = lds_byte(wr * 64 + fr, fq * 8), boff = lds_byte(wc * 32 + fr, fq * 8);
#define PG8_SA(b, h) (((b) * 2 + (h)) * HTB)
#define PG8_SB(b, h) ((4 + (b) * 2 + (h)) * HTB)
#define PG8_STAGE(bufoff, gbase, voff) do { _Pragma("unroll") for (int _i = 0; _i < 2; ++_i) \
        __builtin_amdgcn_global_load_lds((const unsigned*)((const char*)(gbase) + (voff)[_i]), (PG8_LAS unsigned*)(lds + (bufoff) + ldsw + _i * 8192), 16, 0, 0); } while (0)
#define PG8_LDA(dst, b, h) do { _Pragma("unroll") for (int m = 0; m < 4; ++m) _Pragma("unroll") for (int k = 0; k < 2; ++k) dst[m][k] = *(const PG8_LAS bf16x8*)(lds + PG8_SA(b, h) + aoff + m * 2048 + k * 1024); } while (0)
#define PG8_LDB(dst, b, h) do { _Pragma("unroll") for (int n = 0; n < 2; ++n) _Pragma("unroll") for (int k = 0; k < 2; ++k) dst[n][k] = *(const PG8_LAS bf16x8*)(lds + PG8_SB(b, h) + boff + n * 2048 + k * 1024); } while (0)
#define PG8_MMA(ai, bj, At, Bt) do { __builtin_amdgcn_s_setprio(1); _Pragma("unroll") for (int m = 0; m < 4; ++m) _Pragma("unroll") for (int n = 0; n < 2; ++n) _Pragma("unroll") for (int k = 0; k < 2; ++k) \
        acc[ai][bj][m][n] = __builtin_amdgcn_mfma_f32_16x16x32_bf16(Bt[n][k], At[m][k], acc[ai][bj][m][n], 0, 0, 0); __builtin_amdgcn_s_setprio(0); } while (0)
#define PG8_WAIT_V(n) asm volatile("s_waitcnt vmcnt(" #n ")" ::: "memory")
#define PG8_WAIT_L(n) asm volatile("s_waitcnt lgkmcnt(" #n ")" ::: "memory")
#define PG8_BAR __builtin_amdgcn_s_barrier()
#define PG8_SCHED __builtin_amdgcn_sched_barrier(0)
    Unit cur, nxt; int ui = 0;
    if (!S.next(0, cur)) return;
    f32x4 acc[2][2][4][2];
#pragma unroll
    for (int a = 0; a < 2; ++a)
#pragma unroll
        for (int b = 0; b < 2; ++b)
#pragma unroll
            for (int m = 0; m < 4; ++m)
#pragma unroll
                for (int n = 0; n < 2; ++n) acc[a][b][m][n] = (f32x4){0.f, 0.f, 0.f, 0.f};
    bf16x8 At[4][2], B0[2][2], B1[2][2];
    const char* cA = (const char*)g.A + (size_t)cur.pm * tstep; const char* cB = (const char*)g.Bt + (size_t)cur.pn * tstep;
    S.a_ready(cur);
    if constexpr (SP2) {
        PG8_STAGE(PG8_SB(0, 0), cB, voffB); PG8_STAGE(PG8_SB(0, 1), cB + hstep, voffB); PG8_STAGE(PG8_SA(0, 0), cA, voffA); PG8_STAGE(PG8_SA(0, 1), cA + hstep, voffA);
        if (wr == 1) PG8_BAR;
        PG8_WAIT_V(2); PG8_BAR;
        PG8_STAGE(PG8_SB(1, 0), cB + kstep, voffB); PG8_STAGE(PG8_SA(1, 0), cA + kstep, voffA); PG8_STAGE(PG8_SB(1, 1), cB + hstep + kstep, voffB);
        PG8_WAIT_V(6); PG8_BAR;
    } else {
        PG8_STAGE(PG8_SB(0, 0), cB, voffB); PG8_STAGE(PG8_SA(0, 0), cA, voffA); PG8_STAGE(PG8_SB(0, 1), cB + hstep, voffB); PG8_STAGE(PG8_SA(0, 1), cA + hstep, voffA);
        if (wr == 1) PG8_BAR;
        PG8_WAIT_V(4); PG8_BAR;
        PG8_STAGE(PG8_SB(1, 0), cB + kstep, voffB); PG8_STAGE(PG8_SA(1, 0), cA + kstep, voffA); PG8_STAGE(PG8_SB(1, 1), cB + hstep + kstep, voffB);
        PG8_WAIT_V(6); PG8_BAR;
    }
    for (;;) {
        const bool has_next = S.next(ui + 1, nxt);
        const char* nA = has_next ? (const char*)g.A + (size_t)nxt.pm * tstep : cA; const char* nB = has_next ? (const char*)g.Bt + (size_t)nxt.pn * tstep : cB;
        for (int t = 0; t < nt; t += 2) {
            const bool last = (t == nt - 2);
            const char* a1 = cA + (size_t)(t + 1) * kstep;
            const char* a2 = last ? nA : cA + (size_t)(t + 2) * kstep; const char* b2 = last ? nB : cB + (size_t)(t + 2) * kstep;
            const char* a3 = a2 + kstep; const char* b3 = b2 + kstep;
            if (last && has_next) S.a_ready(nxt);
            if constexpr (SP2) {
            PG8_LDB(B0, 0, 0); PG8_LDB(B1, 0, 1); PG8_SCHED; PG8_LDA(At, 0, 0); PG8_STAGE(PG8_SA(1, 1), a1 + hstep, voffA);
            PG8_WAIT_V(8); PG8_WAIT_L(0); PG8_BAR; PG8_MMA(0, 0, At, B0); PG8_MMA(0, 1, At, B1); PG8_BAR; PG8_SCHED;
            PG8_LDA(At, 0, 1); PG8_STAGE(PG8_SB(0, 0), b2, voffB); PG8_STAGE(PG8_SB(0, 1), b2 + hstep, voffB); PG8_STAGE(PG8_SA(0, 0), a2, voffA);
            PG8_WAIT_V(8); PG8_WAIT_L(0); PG8_BAR; PG8_MMA(1, 0, At, B0); PG8_MMA(1, 1, At, B1); PG8_BAR; PG8_SCHED;
            PG8_LDB(B0, 1, 0); PG8_LDB(B1, 1, 1); PG8_SCHED; PG8_LDA(At, 1, 0); PG8_STAGE(PG8_SA(0, 1), a2 + hstep, voffA);
            PG8_WAIT_V(8); PG8_WAIT_L(0); PG8_BAR; PG8_MMA(0, 0, At, B0); PG8_MMA(0, 1, At, B1); PG8_BAR; PG8_SCHED;
            PG8_LDA(At, 1, 1); PG8_STAGE(PG8_SB(1, 0), b3, voffB); PG8_STAGE(PG8_SB(1, 1), b3 + hstep, voffB); PG8_STAGE(PG8_SA(1, 0), a3, voffA);
            PG8_WAIT_V(8); PG8_WAIT_L(0); PG8_BAR; PG8_MMA(1, 0, At, B0); PG8_MMA(1, 1, At, B1); PG8_BAR; PG8_SCHED;
            } else {
            PG8_LDB(B0, 0, 0); PG8_SCHED; PG8_LDA(At, 0, 0); PG8_STAGE(PG8_SA(1, 1), a1 + hstep, voffA);
            PG8_WAIT_L(8); PG8_BAR; PG8_WAIT_L(0); PG8_MMA(0, 0, At, B0); PG8_BAR; PG8_SCHED;
            PG8_LDB(B1, 0, 1); PG8_STAGE(PG8_SB(0, 0), b2, voffB);
            PG8_BAR; PG8_WAIT_L(0); PG8_MMA(0, 1, At, B1); PG8_BAR;
            PG8_LDA(At, 0, 1); PG8_STAGE(PG8_SA(0, 0), a2, voffA);
            PG8_BAR; PG8_WAIT_L(0); PG8_MMA(1, 0, At, B0); PG8_BAR; PG8_SCHED;
            PG8_STAGE(PG8_SB(0, 1), b2 + hstep, voffB);
            PG8_WAIT_V(6); PG8_BAR; PG8_MMA(1, 1, At, B1); PG8_BAR;
            PG8_LDB(B0, 1, 0); PG8_SCHED; PG8_LDA(At, 1, 0); PG8_STAGE(PG8_SA(0, 1), a2 + hstep, voffA);
            PG8_WAIT_L(8); PG8_BAR; PG8_WAIT_L(0); PG8_MMA(0, 0, At, B0); PG8_BAR; PG8_SCHED;
            PG8_LDB(B1, 1, 1); PG8_STAGE(PG8_SB(1, 0), b3, voffB);
            PG8_BAR; PG8_WAIT_L(0); PG8_MMA(0, 1, At, B1); PG8_BAR;
            PG8_LDA(At, 1, 1); PG8_STAGE(PG8_SA(1, 0), a3, voffA);
            PG8_BAR; PG8_WAIT_L(0); PG8_MMA(1, 0, At, B0); PG8_BAR; PG8_SCHED;
            PG8_STAGE(PG8_SB(1, 1), b3 + hstep, voffB);
            PG8_WAIT_V(6); PG8_BAR; PG8_MMA(1, 1, At, B1); PG8_BAR;
            }
        }
        if constexpr (ALIGN_EPI) { if (wr == 0) PG8_BAR; }
        if constexpr (!Epi::AFTER_DRAIN) { E(acc, cur, wr, wc, fr, fq); S.done(cur); }
        if (!has_next) break;
#pragma unroll
        for (int a = 0; a < 2; ++a)
#pragma unroll
            for (int b = 0; b < 2; ++b)
#pragma unroll
                for (int m = 0; m < 4; ++m)
#pragma unroll
                    for (int n = 0; n < 2; ++n) acc[a][b][m][n] = (f32x4){0.f, 0.f, 0.f, 0.f};
        cur = nxt; cA = nA; cB = nB; ++ui;
        if constexpr (ALIGN_EPI) { if (wr == 1) PG8_BAR; }
    }
    PG8_WAIT_V(0);
    if constexpr (!ALIGN_EPI) { if (wr == 0) PG8_BAR; }
    PG8_BAR;
    if constexpr (Epi::AFTER_DRAIN) { E.fused(acc, cur, wr, wc, fr, fq, lds, wid, lane); S.done(cur); }
#undef PG8_SA
#undef PG8_SB
#undef PG8_STAGE
#undef PG8_LDA
#undef PG8_LDB
#undef PG8_MMA
#undef PG8_WAIT_V
#undef PG8_WAIT_L
#undef PG8_BAR
#undef PG8_SCHED
}
}
constexpr int D = 2048, BATCH = 4, SEQ = 2048, M = BATCH * SEQ, DFF = 5632;
constexpr int A_H = 8, A_DV = 256, A_DQK = 128, A_L = 64, A_NC = SEQ / A_L, A_INC = 6160;
constexpr int B_H = 16, B_DH = 128;
constexpr float EPS = 1e-6f, LOG2E = 1.4426950408889634f;
constexpr int NWAVES = 8;

constexpr size_t MiB = 1u << 20;
constexpr size_t WS_CTL = 0, CTL_BYTES = 1 * MiB;
constexpr size_t WS_WG = 1 * MiB;
constexpr size_t WS_GATES = 2 * MiB;
constexpr size_t WS_DN = 3 * MiB;
constexpr size_t WS_KPART = 3 * MiB + 512 * 1024;
constexpr size_t WS_FFN = 4 * MiB;
constexpr size_t W1_BYTES = 44 * MiB, FFN_BYTES = 66 * MiB;
constexpr size_t WS_AW = WS_FFN + 8 * FFN_BYTES;
constexpr size_t WS_KVK = WS_AW + 64 * MiB, WS_KVV = WS_KVK + 8 * MiB;
constexpr size_t WS_BQ = WS_KVV + 8 * MiB, WS_BO = WS_BQ + 16 * MiB;
constexpr size_t WS_X = WS_BO + 16 * MiB;
constexpr size_t WS_XN = WS_X + 64 * MiB;
constexpr size_t WS_KB = WS_XN + 32 * MiB;
constexpr size_t WS_VTB = WS_KB + 32 * MiB;
constexpr size_t WS_SCR = WS_VTB + 32 * MiB;
constexpr size_t SCR_ACT = 0;
constexpr size_t SCR_PROJ = 0, SCR_VTA = 64 * MiB, SCR_HSNUM = 96 * MiB, SCR_HS = 160 * MiB;
constexpr size_t SCR_Q = 0, SCR_O = 32 * MiB;
constexpr size_t WS_END = WS_SCR + 256 * MiB;
constexpr int CW_BAR = 4096;

constexpr int LDS_BYTES = 147456;
constexpr int LDSCTL_OFF = 143360;
constexpr int P0_JOBS_OFF = 131072;

#define GAS __attribute__((address_space(1)))
#define LAS __attribute__((address_space(3)))
typedef unsigned short bf16;
typedef unsigned v4u __attribute__((ext_vector_type(4)));
typedef unsigned v2u __attribute__((ext_vector_type(2)));
typedef float f32x4 __attribute__((ext_vector_type(4)));
typedef float f32x2 __attribute__((ext_vector_type(2)));
typedef short bf16x8 __attribute__((ext_vector_type(8)));
typedef __bf16 nbf16x2 __attribute__((ext_vector_type(2)));
#define LDS_WAIT() asm volatile("s_waitcnt lgkmcnt(0)" ::: "memory")
#define MFMA16(a, b, c) __builtin_amdgcn_mfma_f32_16x16x32_bf16((a), (b), (c), 0, 0, 0)
__device__ __forceinline__ unsigned pk2(float lo, float hi) { f32x2 v = {lo, hi}; return __builtin_bit_cast(unsigned, __builtin_convertvector(v, nbf16x2)); }
__device__ __forceinline__ float bflo(unsigned w) { return __builtin_bit_cast(float, w << 16); }
__device__ __forceinline__ float bfhi(unsigned w) { return __builtin_bit_cast(float, w & 0xffff0000u); }
__device__ __forceinline__ float wave_sum(float v) {
#pragma unroll
    for (int o = 1; o < 64; o <<= 1) v += __shfl_xor(v, o);
    return v;
}
#define PHASE_IDS int tid = threadIdx.x; asm volatile("" : "+v"(tid)); const int lane = tid & 63, wave = __builtin_amdgcn_readfirstlane(tid >> 6); \
    const int G = gridDim.x, vcu = (G % 8 == 0) ? ((int)blockIdx.x % 8) * (G / 8) + (int)blockIdx.x / 8 : (int)blockIdx.x; (void)lane; (void)wave; (void)vcu; (void)G;
#define XB_TMO      128
#define XB_XCNT(j)  (256  + 64 * (j))
#define XB_XSUB(j)  (1280 + 64 * (j))
#define XB_XGEN(j)  (2304 + 64 * (j))
#define XB_TOP      3328
#define XB_TOPGEN   3392
#define XCD_BAR_WORDS 3456
#define XB_SPIN_CAP (1u << 18)
#define LAS __attribute__((address_space(3)))

__device__ __forceinline__ unsigned xb_ld(unsigned* p)              { return __hip_atomic_load(p, __ATOMIC_RELAXED, __HIP_MEMORY_SCOPE_AGENT); }
__device__ __forceinline__ unsigned xb_add(unsigned* p, unsigned v) { return __hip_atomic_fetch_add(p, v, __ATOMIC_RELAXED, __HIP_MEMORY_SCOPE_AGENT); }
__device__ __forceinline__ unsigned xb_xcc_id() { return (unsigned)__builtin_amdgcn_s_getreg((3 << 11) | 20) & 0xFu; }
#define XB_SPIN(cond, bar) do { unsigned _sp = 0; while (cond) { __builtin_amdgcn_s_sleep(1); \
    if ((++_sp & 255u) == 0u) { if (xb_ld(&(bar)[XB_TMO])) break; if (_sp > XB_SPIN_CAP) { atomicAdd(&(bar)[XB_TMO], 1u); break; } } } } while (0)

struct XcdBarrier {
    unsigned* bar; unsigned x;
    volatile LAS unsigned* st;
};

__device__ __forceinline__ XcdBarrier xcd_barrier_post(unsigned* bar, volatile LAS unsigned* st) {
    XcdBarrier b; b.bar = bar; b.x = xb_xcc_id(); b.st = st;
    if (threadIdx.x == 0) (void)xb_add(&bar[XB_XCNT(b.x)], 1u);
    return b;
}
__device__ __forceinline__ void xcd_barrier_complete(unsigned* bar, unsigned x, unsigned& nloc, unsigned& nx) {
    const unsigned G = gridDim.x * gridDim.y * gridDim.z;
    unsigned sum, cnt, mine, sp = 0u;
    for (;;) {
        sum = 0u; cnt = 0u; mine = 0u;
#pragma unroll
        for (unsigned j = 0; j < 16; ++j) { const unsigned c = xb_ld(&bar[XB_XCNT(j)]); sum += c; cnt += (c > 0u) ? 1u : 0u; mine = (j == x) ? c : mine; }
        if (sum == G) break;
        __builtin_amdgcn_s_sleep(1);
        if ((++sp & 255u) == 0u) { if (xb_ld(&bar[XB_TMO])) break; if (sp > XB_SPIN_CAP) { atomicAdd(&bar[XB_TMO], 1u); break; } }
    }
    nloc = mine > 0u ? mine : 1u; nx = cnt > 0u ? cnt : 1u;
}

__device__ __forceinline__ void xcd_barrier(const XcdBarrier& b) {
    asm volatile("s_waitcnt vmcnt(0)" ::: "memory");
    __syncthreads();
    if (threadIdx.x == 0) {
        unsigned* bar = b.bar;
        __builtin_amdgcn_s_waitcnt(0);
        unsigned nloc = b.st[0], nx = b.st[1];
        if (nloc == 0u) { xcd_barrier_complete(bar, b.x, nloc, nx); b.st[0] = nloc; b.st[1] = nx; }
        const unsigned old = xb_add(&bar[XB_XSUB(b.x)], 1u);
        const unsigned gen = old / nloc;
        if (old + 1u == (gen + 1u) * nloc) {
            __builtin_amdgcn_fence(__ATOMIC_RELEASE, "agent");
            asm volatile("s_waitcnt vmcnt(0)" ::: "memory");
            const unsigned og = xb_add(&bar[XB_TOP], 1u);
            const unsigned tg = og / nx;
            if (og + 1u == (tg + 1u) * nx) xb_add(&bar[XB_TOPGEN], 1u);
            else XB_SPIN(xb_ld(&bar[XB_TOPGEN]) == tg, bar);
            __builtin_amdgcn_fence(__ATOMIC_ACQUIRE, "agent");
            xb_add(&bar[XB_XGEN(b.x)], 1u);
            asm volatile("s_waitcnt vmcnt(0)" ::: "memory");
        } else {
            XB_SPIN(xb_ld(&bar[XB_XGEN(b.x)]) == gen, bar);
            __builtin_amdgcn_fence(__ATOMIC_ACQUIRE, "agent");
            asm volatile("s_waitcnt vmcnt(0)" ::: "memory");
        }
    }
    __syncthreads();
}
struct Frame { LAS unsigned char* lds; };

struct Job { const float* src; bf16* dst; int ldw, K, c0, nblk, perm, start; };
__device__ __forceinline__ void put_job(LAS Job* J, int& nj, int& start, const float* src, bf16* dst, int ldw, int K, int c0, int ncols, int perm) {
    J[nj].src = src; J[nj].dst = dst; J[nj].ldw = ldw; J[nj].K = K; J[nj].c0 = c0; J[nj].nblk = ncols / 64; J[nj].perm = perm; J[nj].start = start;
    start += (K / 64) * (ncols / 64); ++nj;
}
struct Ptrs {
    const float* in[17]; float* out; unsigned char* ws;
};
typedef const __attribute__((address_space(4))) Ptrs* KArgs;
struct CvtItem { const float* src; bf16* dst; int ldw, K; };
__device__ __forceinline__ bool cvt_get(LAS Job* J, int nj, int total, int it, int& j, CvtItem& d) {
    if (it >= total) return false;
    while (j + 1 < nj && it >= J[j + 1].start) ++j;
    const int local = it - J[j].start, nblk = J[j].nblk, nb = local % nblk, kb = local / nblk, n0 = 64 * nb, K = J[j].K, ldw = J[j].ldw;
    int sc = n0;
    if (J[j].perm) { const int t = n0 >> 8, c = n0 & 255; sc = (c < 128) ? (128 * t + c) : (DFF + 128 * t + (c - 128)); }
    d.src = J[j].src + (size_t)(64 * kb) * ldw + J[j].c0 + sc; d.dst = J[j].dst + (size_t)n0 * K + 64 * kb; d.ldw = ldw; d.K = K;
    return true;
}
__device__ __forceinline__ void cvt_load(f32x4 (&v)[16], const CvtItem& d, int lane) {
    const float* p = d.src + (size_t)(lane >> 4) * d.ldw + 4 * (lane & 15);
#pragma unroll
    for (int i = 0; i < 16; ++i) v[i] = *(const f32x4*)(p + (size_t)(4 * i) * d.ldw);
}
__device__ __forceinline__ void cvt_proc(const f32x4 (&v)[16], const CvtItem& d, LAS float* scr, int lane) {
#pragma unroll
    for (int i = 0; i < 16; ++i) { const int k = 4 * i + (lane >> 4), pcg = (lane & 15) ^ ((k >> 3) & 7); *(LAS f32x4*)(scr + k * 64 + 4 * pcg) = v[i]; }
    LDS_WAIT();
    const int c = lane & 7;
#pragma unroll
    for (int j = 0; j < 8; ++j) { const int nrow = (lane >> 3) + 8 * j; const LAS float* s = scr + (8 * c) * 64 + 4 * ((nrow >> 2) ^ c) + (nrow & 3);
        v4u o; o.x = pk2(s[0 * 64], s[1 * 64]); o.y = pk2(s[2 * 64], s[3 * 64]); o.z = pk2(s[4 * 64], s[5 * 64]); o.w = pk2(s[6 * 64], s[7 * 64]);
        *(v4u*)(d.dst + (size_t)nrow * d.K + 8 * c) = o; }
    LDS_WAIT();
}
__device__ __forceinline__ void p0_convert(const Frame& F, KArgs Pp) {
#define P (*Pp)
    PHASE_IDS
    LAS Job* J = (LAS Job*)(F.lds + P0_JOBS_OFF);
    LAS int* JN = (LAS int*)(F.lds + P0_JOBS_OFF + 40 * 40);
    if (tid == 0) {
        int nj = 0, start = 0; unsigned char* ws = P.ws;
        for (int f = 0; f < 8; ++f) { const int l = f >> 1, which = f & 1;
            const float* win = (which ? P.in[6] : P.in[2]) + (size_t)l * D * (2 * DFF);
            const float* wout = (which ? P.in[7] : P.in[3]) + (size_t)l * DFF * D;
            put_job(J, nj, start, win, (bf16*)(ws + WS_FFN + f * FFN_BYTES), 2 * DFF, D, 0, 2 * DFF, 1);
            put_job(J, nj, start, wout, (bf16*)(ws + WS_FFN + f * FFN_BYTES + W1_BYTES), D, DFF, 0, D, 0); }
        for (int l = 0; l < 2; ++l) { const float* w = P.in[8] + (size_t)l * D * A_INC; unsigned char* base = ws + WS_AW + (size_t)l * 32 * MiB;
            put_job(J, nj, start, w, (bf16*)base, A_INC, D, 0, 2048, 0);
            put_job(J, nj, start, w, (bf16*)base + (size_t)2048 * D, A_INC, D, 4096, 2048, 0);
            put_job(J, nj, start, w, (bf16*)(base + 16 * MiB), A_INC, D, 2048, 2048, 0);
            put_job(J, nj, start, P.in[11] + (size_t)l * D * D, (bf16*)(base + 24 * MiB), D, D, 0, D, 0); }
        put_job(J, nj, start, P.in[13], (bf16*)(ws + WS_KVK), 2 * D, D, 0, D, 0);
        put_job(J, nj, start, P.in[13], (bf16*)(ws + WS_KVV), 2 * D, D, D, D, 0);
        for (int j = 0; j < 2; ++j) {
            put_job(J, nj, start, P.in[14] + (size_t)j * D * D, (bf16*)(ws + WS_BQ + (size_t)j * 8 * MiB), D, D, 0, D, 0);
            put_job(J, nj, start, P.in[15] + (size_t)j * D * D, (bf16*)(ws + WS_BO + (size_t)j * 8 * MiB), D, D, 0, D, 0); }
        JN[0] = nj; JN[1] = start;
        J[nj].start = start;
    }
    __syncthreads();
    const int nj = JN[0], total = JN[1];
    LAS float* scr = (LAS float*)(F.lds + wave * 16384);
    const int gw = vcu * NWAVES + wave, NGW = G * NWAVES;
    { int j = 0, it = gw; f32x4 va[16], vb[16]; CvtItem da, db;
      bool ha = cvt_get(J, nj, total, it, j, da); if (ha) cvt_load(va, da, lane);
      while (ha) {
          it += NGW; const bool hb = cvt_get(J, nj, total, it, j, db); if (hb) cvt_load(vb, db, lane);
          cvt_proc(va, da, scr, lane);
          if (!hb) break;
          it += NGW; ha = cvt_get(J, nj, total, it, j, da); if (ha) cvt_load(va, da, lane);
          cvt_proc(vb, db, scr, lane);
      } }
    { float* wg = (float*)(P.ws + WS_WG);
      for (int i = (vcu * NWAVES + wave) * 64 + lane; i < 2 * D * 16; i += G * NWAVES * 64) { const int l = i >> 15, k = (i >> 4) & (D - 1), jj = i & 15;
          wg[i] = P.in[8][(size_t)l * D * A_INC + (size_t)k * A_INC + 6144 + jj]; } }
    __syncthreads();
#undef P
}

__device__ __forceinline__ void norm_phase(const Frame& F, const float* xin, const float* gain, bf16* xn, bool gates, const float* wg, const float* bg, float* gout) {
    PHASE_IDS
    const int gw = vcu * NWAVES + wave, NGW = G * NWAVES;
    f32x4 gv[8];
#pragma unroll
    for (int j = 0; j < 8; ++j) gv[j] = *(const f32x4*)(gain + 256 * j + 4 * lane);
    for (int m = gw; m < M; m += NGW) {
        const f32x4* xr = (const f32x4*)(xin + (size_t)m * D) + lane;
        f32x4 v[8]; float s = 0.f;
#pragma unroll
        for (int j = 0; j < 8; ++j) { v[j] = xr[64 * j]; s += (v[j].x * v[j].x + v[j].y * v[j].y) + (v[j].z * v[j].z + v[j].w * v[j].w); }
        const float rstd = 1.0f / sqrtf(wave_sum(s) * (1.0f / D) + EPS);
        v2u* o8 = (v2u*)(xn + (size_t)m * D) + lane;
#pragma unroll
        for (int j = 0; j < 8; ++j) { v[j] = v[j] * rstd * gv[j]; v2u w; w.x = pk2(v[j].x, v[j].y); w.y = pk2(v[j].z, v[j].w); o8[64 * j] = w; }
        if (gates) {
            float acc[16];
#pragma unroll
            for (int q = 0; q < 16; ++q) acc[q] = 0.f;
#pragma unroll
            for (int j = 0; j < 8; ++j)
#pragma unroll
                for (int c = 0; c < 4; ++c) { const int k = 256 * j + 4 * lane + c; const f32x4* wp = (const f32x4*)(wg + (size_t)k * 16); const float y = v[j][c];
                    const f32x4 w0 = wp[0], w1 = wp[1], w2 = wp[2], w3 = wp[3];
                    acc[0] += y * w0.x; acc[1] += y * w0.y; acc[2] += y * w0.z; acc[3] += y * w0.w; acc[4] += y * w1.x; acc[5] += y * w1.y; acc[6] += y * w1.z; acc[7] += y * w1.w;
                    acc[8] += y * w2.x; acc[9] += y * w2.y; acc[10] += y * w2.z; acc[11] += y * w2.w; acc[12] += y * w3.x; acc[13] += y * w3.y; acc[14] += y * w3.z; acc[15] += y * w3.w; }
            float r8[8], r4[4], r2[2], r1;
            { const bool up = (lane & 32) != 0;
#pragma unroll
              for (int i = 0; i < 8; ++i) { const float keep = up ? acc[i + 8] : acc[i], send = up ? acc[i] : acc[i + 8]; r8[i] = keep + __shfl_xor(send, 32); } }
            { const bool up = (lane & 16) != 0;
#pragma unroll
              for (int i = 0; i < 4; ++i) { const float keep = up ? r8[i + 4] : r8[i], send = up ? r8[i] : r8[i + 4]; r4[i] = keep + __shfl_xor(send, 16); } }
            { const bool up = (lane & 8) != 0;
#pragma unroll
              for (int i = 0; i < 2; ++i) { const float keep = up ? r4[i + 2] : r4[i], send = up ? r4[i] : r4[i + 2]; r2[i] = keep + __shfl_xor(send, 8); } }
            { const bool up = (lane & 4) != 0; const float keep = up ? r2[1] : r2[0], send = up ? r2[0] : r2[1]; r1 = keep + __shfl_xor(send, 4); }
            r1 += __shfl_xor(r1, 1); r1 += __shfl_xor(r1, 2);
            if ((lane & 3) == 0) { const int jj = ((lane >> 5) & 1) * 8 + ((lane >> 4) & 1) * 4 + ((lane >> 3) & 1) * 2 + ((lane >> 2) & 1);
                const float gpre = r1 + bg[jj]; float val;
                if (jj < 8) val = 15.0f * tanhf(gpre * (1.0f / 15.0f));
                else val = fminf(gpre, 0.f) - log1pf(expf(-fabsf(gpre)));
                gout[(size_t)m * 16 + jj] = val; }
        }
    }
}
__device__ __forceinline__ void final_norm_phase(const Frame& F, const float* xin, const float* gain, float* out) {
    PHASE_IDS
    const int gw = vcu * NWAVES + wave, NGW = G * NWAVES;
    f32x4 gv[8];
#pragma unroll
    for (int j = 0; j < 8; ++j) gv[j] = *(const f32x4*)(gain + 256 * j + 4 * lane);
    for (int m = gw; m < M; m += NGW) {
        const f32x4* xr = (const f32x4*)(xin + (size_t)m * D) + lane;
        f32x4 v[8]; float s = 0.f;
#pragma unroll
        for (int j = 0; j < 8; ++j) { v[j] = xr[64 * j]; s += (v[j].x * v[j].x + v[j].y * v[j].y) + (v[j].z * v[j].z + v[j].w * v[j].w); }
        const float rstd = 1.0f / sqrtf(wave_sum(s) * (1.0f / D) + EPS);
        f32x4* o = (f32x4*)(out + (size_t)m * D) + lane;
#pragma unroll
        for (int j = 0; j < 8; ++j) o[64 * j] = v[j] * rstd * gv[j];
    }
}
__device__ __forceinline__ void mlstm_finalize_phase(const Frame& F, const float* num, const float* dn, const bf16* proj, const float* hgain, bf16* hs) {
    PHASE_IDS
    const int gw = vcu * NWAVES + wave, NGW = G * NWAVES;
    for (int m = gw; m < M; m += NGW) {
#pragma unroll
        for (int h = 0; h < A_H; ++h) {
            const f32x4 nv = *(const f32x4*)(num + (size_t)m * 2048 + h * 256 + 4 * lane);
            const float rd = 1.0f / dn[(size_t)m * 8 + h];
            const f32x4 hv = nv * rd;
            const float ss = wave_sum((hv.x * hv.x + hv.y * hv.y) + (hv.z * hv.z + hv.w * hv.w));
            const float r = 1.0f / sqrtf(ss * (1.0f / 256.0f) + EPS);
            const f32x4 g = *(const f32x4*)(hgain + h * 256 + 4 * lane);
            const v2u ogw = *(const v2u*)(proj + (size_t)m * 4096 + 2048 + h * 256 + 4 * lane);
            const float o0 = bflo(ogw.x), o1 = bfhi(ogw.x), o2 = bflo(ogw.y), o3 = bfhi(ogw.y);
            const float y0 = hv.x * r * g.x / (1.0f + __expf(-o0)), y1 = hv.y * r * g.y / (1.0f + __expf(-o1));
            const float y2 = hv.z * r * g.z / (1.0f + __expf(-o2)), y3 = hv.w * r * g.w / (1.0f + __expf(-o3));
            v2u w; w.x = pk2(y0, y1); w.y = pk2(y2, y3);
            *(v2u*)(hs + (size_t)m * 2048 + h * 256 + 4 * lane) = w;
        }
    }
}
constexpr int ML_QS = 272, ML_TS = 144;
constexpr int ML_Q0 = 0, ML_K0 = 34816, ML_KT0 = 69632, ML_VT0 = 106496, ML_SW = 124928, ML_SC0 = 134144, ML_END = 137216;
constexpr int ML_QB = 17408, ML_KTB = 18432, ML_VTB = 9216, ML_SCB = 1536;
constexpr int SC_A2 = 0, SC_U2 = 256, SC_DEC = 512, SC_W = 768, SC_FLOOR = 1024, SC_CDEC = 1280;
static_assert(ML_END <= LDSCTL_OFF, "mLSTM LDS map");

__device__ __forceinline__ float scan_add(float x, int lane) {
#pragma unroll
    for (int o = 1; o < 64; o <<= 1) { const float y = __shfl_up(x, o); if (lane >= o) x += y; }
    return x;
}
__device__ __forceinline__ float scan_max(float x, int lane) {
#pragma unroll
    for (int o = 1; o < 64; o <<= 1) { const float y = __shfl_up(x, o); if (lane >= o) x = fmaxf(x, y); }
    return x;
}
__device__ __forceinline__ float mlstm_scalars(LAS unsigned char* sc, const float* gates, int tok0, int h, int lane, float m) {
    const float ig = gates[(size_t)(tok0 + lane) * 16 + h], lf = gates[(size_t)(tok0 + lane) * 16 + 8 + h];
    const float b = scan_add(lf, lane);
    const float u = ig - b;
    const float pm = scan_max(u, lane);
    const float mx = fmaxf(pm, m);
    const float a63 = -__shfl(mx, 63), b63 = __shfl(b, 63);
    ((LAS float*)(sc + SC_A2))[lane] = -mx * LOG2E;
    ((LAS float*)(sc + SC_U2))[lane] = u * LOG2E;
    ((LAS float*)(sc + SC_DEC))[lane] = __expf(m - mx);
    ((LAS float*)(sc + SC_W))[lane] = __expf(u + a63);
    ((LAS float*)(sc + SC_FLOOR))[lane] = __expf(-(b + mx));
    if (lane == 0) ((LAS float*)(sc + SC_CDEC))[0] = __expf(m + a63);
    return b63 - a63;
}
__device__ __forceinline__ void mlstm_phase(const Frame& F, const bf16* proj, const bf16* vta, const float* gates, float* hsnum, float* dnbuf) {
    if (blockIdx.x >= 128) return;
    PHASE_IDS
    LAS unsigned char* lds = F.lds;
    const int w = wave, l15 = lane & 15, g = lane >> 4;
    const int unit = blockIdx.x, bh = unit >> 2, vs = unit & 3, b = bh >> 3, h = bh & 7;
    const int tokb = b * SEQ;
    const int qrow0 = tid >> 4, qc16 = tid & 15;
    const int vrow_p = tid >> 3, vc16 = tid & 7;
    const bf16* qg = proj + (size_t)(tokb + qrow0) * 4096 + h * 128 + qc16 * 8;
    const bf16* vg = vta + (size_t)(h * 256 + vs * 64 + vrow_p) * M + tokb + vc16 * 8;
    v4u rq[2], rk[2], rv;
#define ML_LOAD(c) do { const size_t _t = (size_t)(c) * A_L; \
        rq[0] = *(const v4u*)(qg + _t * 4096); rq[1] = *(const v4u*)(qg + (_t + 32) * 4096); \
        rk[0] = *(const v4u*)(qg + _t * 4096 + 1024); rk[1] = *(const v4u*)(qg + (_t + 32) * 4096 + 1024); \
        rv = *(const v4u*)(vg + _t); } while (0)
#define ML_STORE(bufi) do { \
        _Pragma("unroll") for (int _i = 0; _i < 2; ++_i) { const int _row = qrow0 + 32 * _i; \
            *(LAS v4u*)(lds + ML_Q0 + (bufi) * ML_QB + _row * ML_QS + qc16 * 16) = rq[_i]; \
            *(LAS v4u*)(lds + ML_K0 + (bufi) * ML_QB + _row * ML_QS + qc16 * 16) = rk[_i]; \
            LAS unsigned char* _kt = lds + ML_KT0 + (bufi) * ML_KTB + (qc16 * 8) * ML_TS + _row * 2; \
            *(LAS bf16*)(_kt + 0 * ML_TS) = (bf16)(rk[_i].x & 0xffffu); *(LAS bf16*)(_kt + 1 * ML_TS) = (bf16)(rk[_i].x >> 16); \
            *(LAS bf16*)(_kt + 2 * ML_TS) = (bf16)(rk[_i].y & 0xffffu); *(LAS bf16*)(_kt + 3 * ML_TS) = (bf16)(rk[_i].y >> 16); \
            *(LAS bf16*)(_kt + 4 * ML_TS) = (bf16)(rk[_i].z & 0xffffu); *(LAS bf16*)(_kt + 5 * ML_TS) = (bf16)(rk[_i].z >> 16); \
            *(LAS bf16*)(_kt + 6 * ML_TS) = (bf16)(rk[_i].w & 0xffffu); *(LAS bf16*)(_kt + 7 * ML_TS) = (bf16)(rk[_i].w >> 16); } \
        *(LAS v4u*)(lds + ML_VT0 + (bufi) * ML_VTB + vrow_p * ML_TS + vc16 * 16) = rv; } while (0)
    float mrun = 0.f;
    ML_LOAD(0); ML_STORE(0);
    if (w == 5) mrun = mlstm_scalars(lds + ML_SC0, gates, tokb, h, lane, mrun);
    f32x4 CT[8];
#pragma unroll
    for (int i = 0; i < 8; ++i) CT[i] = (f32x4){0.f, 0.f, 0.f, 0.f};
    const bool aux = (w == 4);
    const int vrow = 16 * (w & 3) + l15;
    LDS_WAIT(); __syncthreads();
    for (int c = 0; c < A_NC; ++c) {
        const int bf = c & 1, tok0 = tokb + c * A_L;
        LAS unsigned char* sQ = lds + ML_Q0 + bf * ML_QB; LAS unsigned char* sK = lds + ML_K0 + bf * ML_QB;
        LAS unsigned char* sKT = lds + ML_KT0 + bf * ML_KTB; LAS unsigned char* sVT = lds + ML_VT0 + bf * ML_VTB; LAS unsigned char* sSC = lds + ML_SC0 + bf * ML_SCB;
        if (c + 1 < A_NC) ML_LOAD(c + 1);
        { const int si = w & 3, tp = w >> 2;
          f32x4 sacc[2] = {(f32x4){0.f, 0.f, 0.f, 0.f}, (f32x4){0.f, 0.f, 0.f, 0.f}};
#pragma unroll
          for (int ks = 0; ks < 4; ++ks) { const bf16x8 a = *(const LAS bf16x8*)(sK + (16 * si + l15) * ML_QS + (32 * ks + 8 * g) * 2);
#pragma unroll
              for (int tt = 0; tt < 2; ++tt) { const bf16x8 bq = *(const LAS bf16x8*)(sQ + (16 * (2 * tp + tt) + l15) * ML_QS + (32 * ks + 8 * g) * 2); sacc[tt] = MFMA16(a, bq, sacc[tt]); } }
          const f32x4 u2 = *(const LAS f32x4*)(sSC + SC_U2 + (16 * si + 4 * g) * 4);
#pragma unroll
          for (int tt = 0; tt < 2; ++tt) { const int t = 16 * (2 * tp + tt) + l15; const float a2 = ((const LAS float*)(sSC + SC_A2))[t]; float e[4];
#pragma unroll
              for (int r = 0; r < 4; ++r) { const int s = 16 * si + 4 * g + r; const float x = sacc[tt][r] * __builtin_amdgcn_exp2f(a2 + u2[r]); e[r] = (s <= t) ? x : 0.f; }
              v2u pw; pw.x = pk2(e[0], e[1]); pw.y = pk2(e[2], e[3]);
              *(LAS v2u*)(lds + ML_SW + t * ML_TS + (16 * si + 4 * g) * 2) = pw; } }
        LDS_WAIT(); __syncthreads();
        if (w < 5) {
            f32x4 intra[4], inter[4];
#pragma unroll
            for (int i = 0; i < 4; ++i) { intra[i] = (f32x4){0.f, 0.f, 0.f, 0.f}; inter[i] = (f32x4){0.f, 0.f, 0.f, 0.f}; }
            const bf16x8 ones8 = (bf16x8){(short)0x3F80, (short)0x3F80, (short)0x3F80, (short)0x3F80, (short)0x3F80, (short)0x3F80, (short)0x3F80, (short)0x3F80};
            const bf16x8 zero8 = (bf16x8){0, 0, 0, 0, 0, 0, 0, 0};
            bf16x8 vraw[2];
#pragma unroll
            for (int ks = 0; ks < 2; ++ks) { vraw[ks] = *(const LAS bf16x8*)(sVT + vrow * ML_TS + (32 * ks + 8 * g) * 2);
                const bf16x8 bfrag = aux ? (l15 == 0 ? ones8 : zero8) : vraw[ks];
#pragma unroll
                for (int ti = 0; ti < 4; ++ti) { const bf16x8 af = *(const LAS bf16x8*)(lds + ML_SW + (16 * ti + l15) * ML_TS + (32 * ks + 8 * g) * 2); intra[ti] = MFMA16(af, bfrag, intra[ti]); } }
#pragma unroll
            for (int p = 0; p < 4; ++p) { v4u bw; bw.x = pk2(CT[2 * p][0], CT[2 * p][1]); bw.y = pk2(CT[2 * p][2], CT[2 * p][3]); bw.z = pk2(CT[2 * p + 1][0], CT[2 * p + 1][1]); bw.w = pk2(CT[2 * p + 1][2], CT[2 * p + 1][3]);
                const bf16x8 bfrag = __builtin_bit_cast(bf16x8, bw);
#pragma unroll
                for (int ti = 0; ti < 4; ++ti) { const v2u lo = *(const LAS v2u*)(sQ + (16 * ti + l15) * ML_QS + (32 * p + 4 * g) * 2), hi = *(const LAS v2u*)(sQ + (16 * ti + l15) * ML_QS + (32 * p + 16 + 4 * g) * 2);
                    v4u aw; aw.x = lo.x; aw.y = lo.y; aw.z = hi.x; aw.w = hi.y; inter[ti] = MFMA16(__builtin_bit_cast(bf16x8, aw), bfrag, inter[ti]); } }
#pragma unroll
            for (int ti = 0; ti < 4; ++ti) { const f32x4 dec4 = *(const LAS f32x4*)(sSC + SC_DEC + (16 * ti + 4 * g) * 4); const f32x4 nm = intra[ti] + dec4 * inter[ti];
                if (!aux) {
#pragma unroll
                    for (int r = 0; r < 4; ++r) hsnum[(size_t)(tok0 + 16 * ti + 4 * g + r) * 2048 + h * 256 + vs * 64 + vrow] = nm[r];
                } else if (l15 == 0 && vs == 0) { const f32x4 fl4 = *(const LAS f32x4*)(sSC + SC_FLOOR + (16 * ti + 4 * g) * 4);
#pragma unroll
                    for (int r = 0; r < 4; ++r) dnbuf[(size_t)(tok0 + 16 * ti + 4 * g + r) * 8 + h] = fmaxf(fabsf(nm[r]), fl4[r]); } }
            const float cdec = ((const LAS float*)(sSC + SC_CDEC))[0];
            bf16x8 bwv[2];
#pragma unroll
            for (int ks = 0; ks < 2; ++ks) { const f32x4 w0 = *(const LAS f32x4*)(sSC + SC_W + (32 * ks + 8 * g) * 4), w1 = *(const LAS f32x4*)(sSC + SC_W + (32 * ks + 8 * g + 4) * 4);
                const v4u raw = __builtin_bit_cast(v4u, vraw[ks]); v4u o;
                if (aux) { const bool on = (l15 == 0); o.x = on ? pk2(w0.x, w0.y) : 0u; o.y = on ? pk2(w0.z, w0.w) : 0u; o.z = on ? pk2(w1.x, w1.y) : 0u; o.w = on ? pk2(w1.z, w1.w) : 0u; }
                else { o.x = pk2(bflo(raw.x) * w0.x, bfhi(raw.x) * w0.y); o.y = pk2(bflo(raw.y) * w0.z, bfhi(raw.y) * w0.w); o.z = pk2(bflo(raw.z) * w1.x, bfhi(raw.z) * w1.y); o.w = pk2(bflo(raw.w) * w1.z, bfhi(raw.w) * w1.w); }
                bwv[ks] = __builtin_bit_cast(bf16x8, o); }
#pragma unroll
            for (int dt = 0; dt < 8; ++dt) { CT[dt] = CT[dt] * cdec;
#pragma unroll
                for (int ks = 0; ks < 2; ++ks) { const bf16x8 af = *(const LAS bf16x8*)(sKT + (16 * dt + l15) * ML_TS + (32 * ks + 8 * g) * 2); CT[dt] = MFMA16(af, bwv[ks], CT[dt]); } }
        } else if (w == 5) {
            if (c + 1 < A_NC) mrun = mlstm_scalars(lds + ML_SC0 + (bf ^ 1) * ML_SCB, gates, tok0 + A_L, h, lane, mrun);
        }
        if (c + 1 < A_NC) ML_STORE(bf ^ 1);
        LDS_WAIT(); __syncthreads();
    }
#undef ML_LOAD
#undef ML_STORE
}
constexpr int AT_KS = 272, AT_VS = 144, AT_KB = 17408, AT_VB = 18432, AT_K0 = 0, AT_V0 = 34816, AT_FLAGS = 71680, AT_END = 71680 + 64;
constexpr float AT_EXIT = 104.0f;
__device__ __forceinline__ void knorm_phase(const Frame& F, const bf16* KB, float* kpart) {
    PHASE_IDS
    const int gw = vcu * NWAVES + wave, NGW = G * NWAVES, g = lane >> 4;
    float wmax[4][4];
#pragma unroll
    for (int bb = 0; bb < 4; ++bb)
#pragma unroll
        for (int j = 0; j < 4; ++j) wmax[bb][j] = 0.f;
    for (int m = gw; m < M; m += NGW) {
        const int b = m >> 11;
#pragma unroll
        for (int j = 0; j < 4; ++j) { const v4u r = *(const v4u*)(KB + (size_t)m * 2048 + 8 * (lane + 64 * j));
            float s = bflo(r.x) * bflo(r.x) + bfhi(r.x) * bfhi(r.x) + bflo(r.y) * bflo(r.y) + bfhi(r.y) * bfhi(r.y) + bflo(r.z) * bflo(r.z) + bfhi(r.z) * bfhi(r.z) + bflo(r.w) * bflo(r.w) + bfhi(r.w) * bfhi(r.w);
            s += __shfl_xor(s, 1); s += __shfl_xor(s, 2); s += __shfl_xor(s, 4); s += __shfl_xor(s, 8);
#pragma unroll
            for (int bb = 0; bb < 4; ++bb) if (b == bb) wmax[bb][j] = fmaxf(wmax[bb][j], s); }
    }
    LAS float* tab = (LAS float*)F.lds;
    if ((lane & 15) == 0) {
#pragma unroll
        for (int bb = 0; bb < 4; ++bb)
#pragma unroll
            for (int j = 0; j < 4; ++j) tab[wave * 64 + bb * 16 + g + 4 * j] = wmax[bb][j];
    }
    LDS_WAIT(); __syncthreads();
    if (tid < 64) { float v = tab[tid];
#pragma unroll
        for (int ww = 1; ww < 8; ++ww) v = fmaxf(v, tab[ww * 64 + tid]);
        kpart[(size_t)blockIdx.x * 64 + tid] = v; }
    LDS_WAIT(); __syncthreads();
}
__device__ __forceinline__ void attn_phase(const Frame& F, const bf16* Q, const bf16* KB, const bf16* VT, bf16* O, const float* kpart) {
    PHASE_IDS
    LAS unsigned char* lds = F.lds;
    const int w = wave, l15 = lane & 15, g = lane >> 4;
    const int krow = tid >> 4, kc16 = tid & 15, vrow = tid >> 3, vc16 = tid & 7;
    for (int pp = blockIdx.x; pp < 512; pp += G) {
        const int bh = pp >> 3, ii = pp & 7, b = bh >> 4, h = bh & 15, tokb = b * SEQ;
        float kn2 = 0.f;
        for (int i = lane; i < G; i += 64) kn2 = fmaxf(kn2, kpart[(size_t)i * 64 + bh]);
#pragma unroll
        for (int o = 1; o < 64; o <<= 1) kn2 = fmaxf(kn2, __shfl_xor(kn2, o));
        const float kn = sqrtf(kn2) * 1.001f;
        for (int half = 0; half < 2; ++half) {
            const int qb = half ? (15 - ii) : ii, t0 = 128 * qb, tq0 = t0 + 16 * w, t = tq0 + l15;
            bf16x8 qf[4];
#pragma unroll
            for (int ks = 0; ks < 4; ++ks) qf[ks] = *(const bf16x8*)(Q + (size_t)(tokb + t) * 2048 + h * 128 + 32 * ks + 8 * g);
            float qn2 = 0.f;
#pragma unroll
            for (int ks = 0; ks < 4; ++ks) { const v4u r = __builtin_bit_cast(v4u, qf[ks]);
                qn2 += bflo(r.x) * bflo(r.x) + bfhi(r.x) * bfhi(r.x) + bflo(r.y) * bflo(r.y) + bfhi(r.y) * bfhi(r.y) + bflo(r.z) * bflo(r.z) + bfhi(r.z) * bfhi(r.z) + bflo(r.w) * bflo(r.w) + bfhi(r.w) * bfhi(r.w); }
            qn2 += __shfl_xor(qn2, 16); qn2 += __shfl_xor(qn2, 32);
            const float zb = sqrtf(qn2) * 1.001f * kn + AT_EXIT;
            f32x4 OT[8];
#pragma unroll
            for (int i = 0; i < 8; ++i) OT[i] = (f32x4){0.f, 0.f, 0.f, 0.f};
            float R = 0.f;
            const int nkb = 2 * qb + 2;
            const bf16* kg = KB + (size_t)(tokb + krow) * 2048 + h * 128 + kc16 * 8;
            const bf16* vg = VT + (size_t)(h * 128 + vrow) * M + tokb + vc16 * 8;
            v4u rk[2], rv[2];
#define AT_LOAD(kb) do { const size_t _s0 = (size_t)(kb) * 64; rk[0] = *(const v4u*)(kg + _s0 * 2048); rk[1] = *(const v4u*)(kg + (_s0 + 32) * 2048); \
                rv[0] = *(const v4u*)(vg + _s0); rv[1] = *(const v4u*)(vg + (size_t)64 * M + _s0); } while (0)
#define AT_STORE(bufi) do { *(LAS v4u*)(lds + AT_K0 + (bufi) * AT_KB + krow * AT_KS + kc16 * 16) = rk[0]; *(LAS v4u*)(lds + AT_K0 + (bufi) * AT_KB + (krow + 32) * AT_KS + kc16 * 16) = rk[1]; \
                *(LAS v4u*)(lds + AT_V0 + (bufi) * AT_VB + vrow * AT_VS + vc16 * 16) = rv[0]; *(LAS v4u*)(lds + AT_V0 + (bufi) * AT_VB + (vrow + 64) * AT_VS + vc16 * 16) = rv[1]; } while (0)
            AT_LOAD(nkb - 1); AT_STORE(0);
            if (lane == 0) { ((LAS unsigned*)(lds + AT_FLAGS))[w] = 0u; ((LAS unsigned*)(lds + AT_FLAGS))[8 + w] = 0u; }
            LDS_WAIT(); __syncthreads();
            bool wdone = false;
            for (int it = 0; it < nkb; ++it) {
                const int kb = nkb - 1 - it, bf = it & 1, s0 = 64 * kb;
                if (it + 1 < nkb) AT_LOAD(kb - 1);
                if (s0 <= tq0 && !wdone) {
                    LAS unsigned char* sK = lds + AT_K0 + bf * AT_KB; LAS unsigned char* sV = lds + AT_V0 + bf * AT_VB;
                    f32x4 z[4];
#pragma unroll
                    for (int si = 0; si < 4; ++si) { z[si] = (f32x4){0.f, 0.f, 0.f, 0.f};
#pragma unroll
                        for (int ks = 0; ks < 4; ++ks) { const bf16x8 a = *(const LAS bf16x8*)(sK + (16 * si + l15) * AT_KS + (32 * ks + 8 * g) * 2); z[si] = MFMA16(a, qf[ks], z[si]); } }
                    float L[4][4], P[4], tot[4], sufg[4];
#pragma unroll
                    for (int si = 0; si < 4; ++si) { P[si] = 0.f;
#pragma unroll
                        for (int r = 0; r < 4; ++r) { const int s = s0 + 16 * si + 4 * g + r; const float zz = z[si][r];
                            const float sp = fmaxf(zz, 0.f) + __logf(1.0f + __expf(-fabsf(zz)));
                            L[si][r] = (s < t) ? sp : 0.f; P[si] += L[si][r]; } }
#pragma unroll
                    for (int si = 0; si < 4; ++si) { const float a = __shfl_xor(P[si], 16), bb = __shfl_xor(P[si], 32), cc = __shfl_xor(P[si], 48);
                        tot[si] = P[si] + a + bb + cc; sufg[si] = (g == 0) ? (a + bb + cc) : (g == 1) ? (bb + cc) : (g == 2) ? a : 0.f; }
                    float hi = 0.f; f32x4 att[4];
#pragma unroll
                    for (int si = 3; si >= 0; --si) { float run = R + hi + sufg[si];
#pragma unroll
                        for (int r = 3; r >= 0; --r) { const int s = s0 + 16 * si + 4 * g + r; run += L[si][r]; att[si][r] = (s < t) ? __expf(z[si][r] - run) : 0.f; }
                        hi += tot[si]; }
                    R += hi;
#pragma unroll
                    for (int p = 0; p < 2; ++p) { v4u bw; bw.x = pk2(att[2 * p][0], att[2 * p][1]); bw.y = pk2(att[2 * p][2], att[2 * p][3]); bw.z = pk2(att[2 * p + 1][0], att[2 * p + 1][1]); bw.w = pk2(att[2 * p + 1][2], att[2 * p + 1][3]);
                        const bf16x8 bfrag = __builtin_bit_cast(bf16x8, bw);
#pragma unroll
                        for (int dt = 0; dt < 8; ++dt) { const v2u lo = *(const LAS v2u*)(sV + (16 * dt + l15) * AT_VS + (32 * p + 4 * g) * 2), hi2 = *(const LAS v2u*)(sV + (16 * dt + l15) * AT_VS + (32 * p + 16 + 4 * g) * 2);
                            v4u aw; aw.x = lo.x; aw.y = lo.y; aw.z = hi2.x; aw.w = hi2.y; OT[dt] = MFMA16(__builtin_bit_cast(bf16x8, aw), bfrag, OT[dt]); } }
                    wdone = __all(R > zb) != 0;
                }
                if (lane == 0) ((LAS unsigned*)(lds + AT_FLAGS))[8 * bf + w] = wdone ? 1u : 0u;
                if (it + 1 < nkb) AT_STORE(bf ^ 1);
                LDS_WAIT(); __syncthreads();
                const v4u f0 = *(const LAS v4u*)(lds + AT_FLAGS + 32 * bf), f1 = *(const LAS v4u*)(lds + AT_FLAGS + 32 * bf + 16);
                if ((f0.x & f0.y & f0.z & f0.w & f1.x & f1.y & f1.z & f1.w) != 0u) break;
            }
#undef AT_LOAD
#undef AT_STORE
            bf16* orow = O + (size_t)(tokb + t) * 2048 + h * 128 + 4 * g;
#pragma unroll
            for (int dt = 0; dt < 8; ++dt) { v2u ow; ow.x = pk2(OT[dt][0], OT[dt][1]); ow.y = pk2(OT[dt][2], OT[dt][3]); *(v2u*)(orow + 16 * dt) = ow; }
            LDS_WAIT(); __syncthreads();
        }
    }
}
#ifndef SKELETON
#define SKELETON 0
#endif
#ifndef REP_P0
#define REP_P0 1
#endif
#ifndef REP_NORM
#define REP_NORM 1
#endif
#ifndef REP_G1
#define REP_G1 1
#endif
#ifndef REP_GP
#define REP_GP 1
#endif
#ifndef REP_ML
#define REP_ML 1
#endif
#ifndef REP_AT
#define REP_AT 1
#endif
#ifndef REP_BAR
#define REP_BAR 1
#endif
#define OPQ_S(x) asm volatile("" : "+s"(x))
__global__ void __launch_bounds__(NWAVES * 64, 2) fwd_kernel(Ptrs Pdummy) {
    extern __shared__ __attribute__((aligned(16))) unsigned char lds_raw[];
    KArgs kp0 = (KArgs)__builtin_amdgcn_kernarg_segment_ptr();
    Frame F;
    F.lds = (LAS unsigned char*)lds_raw;
    if (threadIdx.x < 4) ((LAS unsigned*)(F.lds + LDSCTL_OFF))[threadIdx.x] = 0u;
    __syncthreads();
    XcdBarrier bar = xcd_barrier_post((unsigned*)(kp0->ws + WS_CTL) + CW_BAR, (volatile LAS unsigned*)(F.lds + LDSCTL_OFF));
#define GRID_BAR() do { for (int rb_ = 0; rb_ < REP_BAR; ++rb_) xcd_barrier(bar); } while (0)

    for (int rep = 0; rep < REP_P0; ++rep) p0_convert(F, kp0);
    GRID_BAR();

    for (int st = 0; st < 13; ++st) {
#define DECODE(kp_) KArgs kp_ = kp0; OPQ_S(kp_); int st_ = st; OPQ_S(st_); \
        const int sb = (st_ < 6) ? st_ : st_ - 1, l = sb / 3, ty = sb - 3 * l; (void)ty; \
        const bool is_kv = (st_ == 6), is_ffn = !is_kv && (ty != 1), is_ml = !is_kv && (ty == 1) && (l < 2), is_at = !is_kv && (ty == 1) && (l >= 2); (void)is_ffn; (void)is_ml; (void)is_at; \
        unsigned char* ws = kp_->ws; unsigned char* scr = ws + WS_SCR; (void)scr; \
        float* X = (float*)(ws + WS_X); bf16* XN = (bf16*)(ws + WS_XN); (void)X; (void)XN; \
        const float* xcur = (st_ == 0) ? kp_->in[0] : X; (void)xcur;
        int kind;
        { DECODE(kp)
          kind = is_kv ? 3 : is_ffn ? 0 : is_ml ? 1 : 2;
          const float* gain = is_kv ? kp->in[12] : ((ty == 0 ? kp->in[1] : ty == 1 ? kp->in[4] : kp->in[5]) + (size_t)l * D);
          if (st_ == 7) knorm_phase(F, (const bf16*)(ws + WS_KB), (float*)(ws + WS_KPART));
          for (int rep = 0; rep < REP_NORM; ++rep) norm_phase(F, xcur, gain, XN, is_ml, (const float*)(ws + WS_WG) + (size_t)(l & 1) * D * 16, kp->in[9] + (l & 1) * 16, (float*)(ws + WS_GATES)); }
        GRID_BAR();
        if (kind == 0) {
#if !SKELETON && !defined(NO_G1)
            { DECODE(kp)
              const int f = 2 * l + (ty == 2 ? 1 : 0);
              pg8::Gemm gm{XN, (const bf16*)(ws + WS_FFN + (size_t)f * FFN_BYTES), M, 2 * DFF, D}; pg8::StaticOrder S; S.init(M, 2 * DFF, (int)gridDim.x, (int)blockIdx.x); pg8::EpiSwiGLU E{(bf16*)(scr + SCR_ACT), DFF};
              for (int rep = 0; rep < REP_G1; ++rep) pg8::gemm_phase<pg8::EpiSwiGLU, pg8::StaticOrder, true, true>(F.lds, gm, S, E); }
#endif
            GRID_BAR();
        } else {
#if !SKELETON && !defined(NO_GP)
            for (int ci = 0; ci < (kind == 2 ? 1 : 2); ++ci) {
                DECODE(kp)
                const unsigned char* awl = ws + WS_AW + (size_t)(l & 1) * 32 * MiB;
                const bf16 *a, *b; bf16* o; int Mx, Nx, ld, sc0; float scv = 0.08838834764831845f;
                if (ci == 0) { a = XN; Mx = M;
                    if (is_ml)      { b = (const bf16*)awl; Nx = 4096; o = (bf16*)(scr + SCR_PROJ); ld = 4096; sc0 = 1024; }
                    else if (is_at) { b = (const bf16*)(ws + WS_BQ + (size_t)(l - 2) * 8 * MiB); Nx = 2048; o = (bf16*)(scr + SCR_Q); ld = 2048; sc0 = 2048; }
                    else            { b = (const bf16*)(ws + WS_KVK); Nx = 2048; o = (bf16*)(ws + WS_KB); ld = 2048; sc0 = 0; } }
                else { b = XN; Mx = 2048; Nx = M; ld = M; sc0 = 0;
                    if (is_ml) { a = (const bf16*)(awl + 16 * MiB); o = (bf16*)(scr + SCR_VTA); }
                    else       { a = (const bf16*)(ws + WS_KVV); o = (bf16*)(ws + WS_VTB); } }
                pg8::Gemm gm{a, b, Mx, Nx, D}; pg8::StaticOrder S; S.init(Mx, Nx, (int)gridDim.x, (int)blockIdx.x);
                pg8::EpiBf16 E{o, ld, sc0, scv};
                for (int rep = 0; rep < REP_GP; ++rep) pg8::gemm_phase<pg8::EpiBf16, pg8::StaticOrder, true, true>(F.lds, gm, S, E);
            }
#endif
            GRID_BAR();
            if (kind == 3) continue;
            if (kind == 1) {
#if !SKELETON && !defined(NO_ML)
                { DECODE(kp)
                  for (int rep = 0; rep < REP_ML; ++rep) mlstm_phase(F, (const bf16*)(scr + SCR_PROJ), (const bf16*)(scr + SCR_VTA), (const float*)(ws + WS_GATES), (float*)(scr + SCR_HSNUM), (float*)(ws + WS_DN)); }
#endif
                GRID_BAR();
#if !SKELETON
                { DECODE(kp)
                  mlstm_finalize_phase(F, (const float*)(scr + SCR_HSNUM), (const float*)(ws + WS_DN), (const bf16*)(scr + SCR_PROJ), kp->in[10] + (size_t)l * 2048, (bf16*)(scr + SCR_HS)); }
#endif
                GRID_BAR();
            } else {
#if !SKELETON && !defined(NO_AT)
                { DECODE(kp)
                  for (int rep = 0; rep < REP_AT; ++rep) attn_phase(F, (const bf16*)(scr + SCR_Q), (const bf16*)(ws + WS_KB), (const bf16*)(ws + WS_VTB), (bf16*)(scr + SCR_O), (const float*)(ws + WS_KPART)); }
#endif
                GRID_BAR();
            }
        }
        { DECODE(kp)
#if !SKELETON && !defined(NO_GR)
          const unsigned char* awl = ws + WS_AW + (size_t)(l & 1) * 32 * MiB;
          const int f = 2 * l + (ty == 2 ? 1 : 0);
          const bf16* rA = is_ffn ? (const bf16*)(scr + SCR_ACT) : is_ml ? (const bf16*)(scr + SCR_HS) : (const bf16*)(scr + SCR_O);
          const bf16* rB = is_ffn ? (const bf16*)(ws + WS_FFN + (size_t)f * FFN_BYTES + W1_BYTES) : is_ml ? (const bf16*)(awl + 24 * MiB) : (const bf16*)(ws + WS_BO + (size_t)(l - 2) * 8 * MiB);
          pg8::Gemm gm{rA, rB, M, D, is_ffn ? DFF : D}; pg8::StaticOrder S; S.init(M, D, (int)gridDim.x, (int)blockIdx.x); pg8::EpiRes E{xcur, X, D, is_ffn ? 0.5f : 1.0f};
          pg8::gemm_phase<pg8::EpiRes, pg8::StaticOrder, true, true>(F.lds, gm, S, E);
#else
          PHASE_IDS
          const int gw = vcu * NWAVES + wave, NGW = G * NWAVES;
          for (int m = gw; m < M; m += NGW) { const f32x4* xr = (const f32x4*)(xcur + (size_t)m * D) + lane; f32x4* xo = (f32x4*)(X + (size_t)m * D) + lane;
              for (int j = 0; j < 8; ++j) xo[64 * j] = xr[64 * j]; }
#endif
        }
        GRID_BAR();
    }
    { KArgs kp = kp0; OPQ_S(kp); final_norm_phase(F, (const float*)(kp->ws + WS_X), kp->in[16], kp->out); }
}

extern "C" void kernel_launch(void* const* d_in, const int* in_sizes, int n_in, void* d_out, int out_size, void* d_ws, size_t ws_size, hipStream_t stream) {
    static int grid = 0;
    if (grid == 0) {
        if (n_in != 17 || in_sizes[0] != M * D || out_size != M * D || ws_size < WS_END) {
            fprintf(stderr, "kernel_launch: built for 17 inputs, x/out of %d floats, >= %zu bytes of workspace; got n_in %d, in0 %d, out %d, ws %zu; nothing launched\n", M * D, (size_t)WS_END, n_in, n_in > 0 ? in_sizes[0] : -1, out_size, ws_size);
            grid = -1; return; }
        int dev = 0, cus = 0, per_cu = 0;
        if (hipGetDevice(&dev) != hipSuccess || hipDeviceGetAttribute(&cus, hipDeviceAttributeMultiprocessorCount, dev) != hipSuccess) { fprintf(stderr, "kernel_launch: device query failed\n"); grid = -1; return; }
        if (hipFuncSetAttribute((const void*)fwd_kernel, hipFuncAttributeMaxDynamicSharedMemorySize, LDS_BYTES) != hipSuccess) { fprintf(stderr, "kernel_launch: hipFuncSetAttribute failed\n"); grid = -1; return; }
        if (hipOccupancyMaxActiveBlocksPerMultiprocessor(&per_cu, (const void*)fwd_kernel, NWAVES * 64, LDS_BYTES) != hipSuccess || per_cu < 1)
            fprintf(stderr, "kernel_launch: note: occupancy query reports %d workgroups per CU\n", per_cu);
        (void)hipGetLastError();
        grid = cus;
    }
    if (grid < 0) return;
    if (hipMemsetAsync((char*)d_ws + WS_CTL, 0, CTL_BYTES, stream) != hipSuccess) { fprintf(stderr, "kernel_launch: memset failed\n"); return; }
    Ptrs p{};
    for (int i = 0; i < 17; ++i) p.in[i] = (const float*)d_in[i];
    p.out = (float*)d_out; p.ws = (unsigned char*)d_ws;
    hipLaunchKernelGGL(fwd_kernel, dim3(grid), dim3(NWAVES * 64), LDS_BYTES, stream, p);
    const hipError_t le = hipPeekAtLastError();
    if (le != hipSuccess) fprintf(stderr, "kernel_launch: launch failed: %s (grid %d)\n", hipGetErrorName(le), grid);
}
```

```cpp
#include <hip/hip_runtime.h>
#include <cstdio>
#include <cstdint>
#define CVT_QT 5120
#define CVT_QM 16384
namespace pg8 {
#define PG8_LAS __attribute__((address_space(3)))
typedef unsigned short bf16_t;
typedef short bf16x8 __attribute__((ext_vector_type(8)));
typedef float f32x4 __attribute__((ext_vector_type(4)));
typedef unsigned u32x4 __attribute__((ext_vector_type(4)));
constexpr int BM = 256, BK = 64, HALF = 128, HTB = HALF * BK * 2  , STAGE_BYTES = 8 * HTB, NXCD = 8, WGM = 8;

__host__ __device__ __forceinline__ int lds_byte(int r, int c) { const int st = (r >> 4) * 2 + (c >> 5), rr = r & 15, cc = c & 31, ob = rr * 64 + cc * 2; return st * 1024 + (ob ^ (((ob >> 9) & 1) << 5)); }
__host__ __device__ __forceinline__ void stage_rc(int b, int& R, int& C) { const int st = b / 1024, sb = b % 1024, swz = sb ^ (((sb >> 9) & 1) << 5); R = (st >> 1) * 16 + swz / 64; C = (st & 1) * 32 + (swz % 64) / 2; }
__host__ __device__ __forceinline__ int perm32(int rho) { const int n = rho >> 4, i = rho & 15; return 8 * (i >> 2) + 4 * n + (i & 3); }

struct Unit { int pm, pn; };
struct Gemm { const bf16_t* A; const bf16_t* Bt; int M, N, K; };

struct StaticOrder {
    int nM, nN, nwg, G, c;
    __host__ __device__ void init(int M, int N, int G_, int c_) { nM = M / BM; nN = N / BM; nwg = nM * nN; G = G_; c = c_; }
    __host__ __device__ bool next(int i, Unit& u) const {
        const long L = (long)i * G + c; if (L >= nwg) return false;
        int wgid = (int)L; { const int q = nwg / NXCD, r = nwg % NXCD, xcd = wgid % NXCD, off = wgid / NXCD; wgid = (xcd < r ? xcd * (q + 1) : r * (q + 1) + (xcd - r) * q) + off; }
        const int nig = WGM * nN, gid = wgid / nig, fm = gid * WGM, gsz = (nM - fm) < WGM ? (nM - fm) : WGM;
        u.pm = fm + ((wgid % nig) % gsz); u.pn = (wgid % nig) / gsz; return true;
    }
    __device__ __forceinline__ void a_ready(const Unit&) const {}
    __device__ __forceinline__ void done(const Unit&) const {}
};
__device__ __forceinline__ unsigned cvt_pk_bf16(float lo, float hi) { unsigned r; asm volatile("v_cvt_pk_bf16_f32 %0, %1, %2" : "=v"(r) : "v"(lo), "v"(hi)); return r; }
struct EpiBf16 {
    static constexpr bool PERM = true, AFTER_DRAIN = false;
    bf16_t* O; int ldc; int scale_cols; float sc;
    __device__ __forceinline__ void operator()(const f32x4 (&acc)[2][2][4][2], const Unit& u, int wr, int wc, int fr, int fq) const {
        const int row0 = u.pm * BM + wr * 64 + fr, col0 = u.pn * BM + wc * 32 + 8 * fq;
        const float s = (u.pn * BM < scale_cols) ? sc : 1.0f;
#pragma unroll
        for (int ai = 0; ai < 2; ++ai)
#pragma unroll
            for (int m = 0; m < 4; ++m) { bf16_t* rowp = O + (size_t)(row0 + ai * HALF + m * 16) * ldc + col0;
#pragma unroll
                for (int bj = 0; bj < 2; ++bj) { const f32x4 v0 = acc[ai][bj][m][0] * s, v1 = acc[ai][bj][m][1] * s;
                    u32x4 w; w.x = cvt_pk_bf16(v0[0], v0[1]); w.y = cvt_pk_bf16(v0[2], v0[3]); w.z = cvt_pk_bf16(v1[0], v1[1]); w.w = cvt_pk_bf16(v1[2], v1[3]);
                    *(u32x4*)(rowp + bj * HALF) = w; } }
    }
};
__device__ __forceinline__ float silu_mul(float g, float up) { return g * up * __builtin_amdgcn_rcpf(1.0f + __builtin_amdgcn_exp2f(-1.4426950408889634f * g)); }
struct EpiSwiGLU {
    static constexpr bool PERM = true, AFTER_DRAIN = false;
    bf16_t* O; int ldc;
    __device__ __forceinline__ void operator()(const f32x4 (&acc)[2][2][4][2], const Unit& u, int wr, int wc, int fr, int fq) const {
        const int row0 = u.pm * BM + wr * 64 + fr, col0 = u.pn * HALF + wc * 32 + 8 * fq;
#pragma unroll
        for (int ai = 0; ai < 2; ++ai)
#pragma unroll
            for (int m = 0; m < 4; ++m) { bf16_t* rowp = O + (size_t)(row0 + ai * HALF + m * 16) * ldc + col0;
                const f32x4 g0 = acc[ai][0][m][0], g1 = acc[ai][0][m][1], u0 = acc[ai][1][m][0], u1 = acc[ai][1][m][1];
                u32x4 w; w.x = cvt_pk_bf16(silu_mul(g0[0], u0[0]), silu_mul(g0[1], u0[1])); w.y = cvt_pk_bf16(silu_mul(g0[2], u0[2]), silu_mul(g0[3], u0[3]));
                w.z = cvt_pk_bf16(silu_mul(g1[0], u1[0]), silu_mul(g1[1], u1[1])); w.w = cvt_pk_bf16(silu_mul(g1[2], u1[2]), silu_mul(g1[3], u1[3]));
                *(u32x4*)rowp = w; }
    }
};
struct EpiRes {
    static constexpr bool PERM = false, AFTER_DRAIN = false;
    const float* base; float* out; int ldc; float sc;
    __device__ __forceinline__ void operator()(const f32x4 (&acc)[2][2][4][2], const Unit& u, int wr, int wc, int fr, int fq) const {
        const int row0 = u.pm * BM + wr * 64 + fr, col0 = u.pn * BM + wc * 32 + 4 * fq;
#pragma unroll
        for (int ai = 0; ai < 2; ++ai)
#pragma unroll
            for (int m = 0; m < 4; ++m) { const size_t off = (size_t)(row0 + ai * HALF + m * 16) * ldc + col0;
#pragma unroll
                for (int bj = 0; bj < 2; ++bj)
#pragma unroll
                    for (int n = 0; n < 2; ++n) { const f32x4 bs = *(const f32x4*)(base + off + bj * HALF + n * 16); *(f32x4*)(out + off + bj * HALF + n * 16) = bs + acc[ai][bj][m][n] * sc; }
                asm volatile("" ::: "memory"); }
    }
};
template <class Epi, class Sched, bool ALIGN_EPI = false, bool SP2 = false>
__device__ __forceinline__ void gemm_phase(PG8_LAS unsigned char* lds, const Gemm g, const Sched& S, const Epi& E) {
    int tid_ = threadIdx.x; asm volatile("" : "+v"(tid_));
    const int tid = tid_, wid = __builtin_amdgcn_readfirstlane(tid >> 6), lane = tid & 63, wr = wid >> 2, wc = wid & 3, fr = lane & 15, fq = lane >> 4;
    const int K = g.K, nt = K / BK;
    unsigned voffA[2], voffB[2];
#pragma unroll
    for (int i = 0; i < 2; ++i) { int R, C; stage_rc(tid * 16 + i * 8192, R, C); const int Rb = Epi::PERM ? ((R & ~31) + perm32(R & 31)) : R;
        voffA[i] = (unsigned)(R * K + C) * 2u; voffB[i] = (unsigned)(Rb * K + C) * 2u; }
    const size_t kstep = (size_t)(BK * 2);
    const size_t hstep = (size_t)HALF * K * 2;
    const size_t tstep = 2 * hstep;
    const unsigned ldsw = (unsigned)wid * 1024u;
    const int aoff = lds_byte(wr * 64 + fr, fq * 8), boff = lds_byte(wc * 32 + fr, fq * 8);
#define PG8_SA(b, h) (((b) * 2 + (h)) * HTB)
#define PG8_SB(b, h) ((4 + (b) * 2 + (h)) * HTB)
#define PG8_STAGE(bufoff, gbase, voff) do { _Pragma("unroll") for (int _i = 0; _i < 2; ++_i) \
        __builtin_amdgcn_global_load_lds((const unsigned*)((const char*)(gbase) + (voff)[_i]), (PG8_LAS unsigned*)(lds + (bufoff) + ldsw + _i * 8192), 16, 0, 0); } while (0)
#define PG8_LDA(dst, b, h) do { _Pragma("unroll") for (int m = 0; m < 4; ++m) _Pragma("unroll") for (int k = 0; k < 2; ++k) dst[m][k] = *(const PG8_LAS bf16x8*)(lds + PG8_SA(b, h) + aoff + m * 2048 + k * 1024); } while (0)
#define PG8_LDB(dst, b, h) do { _Pragma("unroll") for (int n = 0; n < 2; ++n) _Pragma("unroll") for (int k = 0; k < 2; ++k) dst[n][k] = *(const PG8_LAS bf16x8*)(lds + PG8_SB(b, h) + boff + n * 2048 + k * 1024); } while (0)
#define PG8_MMA(ai, bj, At, Bt) do { __builtin_amdgcn_s_setprio(1); _Pragma("unroll") for (int m = 0; m < 4; ++m) _Pragma("unroll") for (int n = 0; n < 2; ++n) _Pragma("unroll") for (int k = 0; k < 2; ++k) \
        acc[ai][bj][m][n] = __builtin_amdgcn_mfma_f32_16x16x32_bf16(Bt[n][k], At[m][k], acc[ai][bj][m][n], 0, 0, 0); __builtin_amdgcn_s_setprio(0); } while (0)
#define PG8_WAIT_V(n) asm volatile("s_waitcnt vmcnt(" #n ")" ::: "memory")
#define PG8_WAIT_L(n) asm volatile("s_waitcnt lgkmcnt(" #n ")" ::: "memory")
#define PG8_BAR __builtin_amdgcn_s_barrier()
#define PG8_SCHED __builtin_amdgcn_sched_barrier(0)
    Unit cur, nxt; int ui = 0;
    if (!S.next(0, cur)) return;
    f32x4 acc[2][2][4][2];
#pragma unroll
    for (int a = 0; a < 2; ++a)
#pragma unroll
        for (int b = 0; b < 2; ++b)
#pragma unroll
            for (int m = 0; m < 4; ++m)
#pragma unroll
                for (int n = 0; n < 2; ++n) acc[a][b][m][n] = (f32x4){0.f, 0.f, 0.f, 0.f};
    bf16x8 At[4][2], B0[2][2], B1[2][2];
    const char* cA = (const char*)g.A + (size_t)cur.pm * tstep; const char* cB = (const char*)g.Bt + (size_t)cur.pn * tstep;
    S.a_ready(cur);
    if constexpr (SP2) {
        PG8_STAGE(PG8_SB(0, 0), cB, voffB); PG8_STAGE(PG8_SB(0, 1), cB + hstep, voffB); PG8_STAGE(PG8_SA(0, 0), cA, voffA); PG8_STAGE(PG8_SA(0, 1), cA + hstep, voffA);
        if (wr == 1) PG8_BAR;
        PG8_WAIT_V(2); PG8_BAR;
        PG8_STAGE(PG8_SB(1, 0), cB + kstep, voffB); PG8_STAGE(PG8_SA(1, 0), cA + kstep, voffA); PG8_STAGE(PG8_SB(1, 1), cB + hstep + kstep, voffB);
        PG8_WAIT_V(6); PG8_BAR;
    } else {
        PG8_STAGE(PG8_SB(0, 0), cB, voffB); PG8_STAGE(PG8_SA(0, 0), cA, voffA); PG8_STAGE(PG8_SB(0, 1), cB + hstep, voffB); PG8_STAGE(PG8_SA(0, 1), cA + hstep, voffA);
        if (wr == 1) PG8_BAR;
        PG8_WAIT_V(4); PG8_BAR;
        PG8_STAGE(PG8_SB(1, 0), cB + kstep, voffB); PG8_STAGE(PG8_SA(1, 0), cA + kstep, voffA); PG8_STAGE(PG8_SB(1, 1), cB + hstep + kstep, voffB);
        PG8_WAIT_V(6); PG8_BAR;
    }
    for (;;) {
        const bool has_next = S.next(ui + 1, nxt);
        const char* nA = has_next ? (const char*)g.A + (size_t)nxt.pm * tstep : cA; const char* nB = has_next ? (const char*)g.Bt + (size_t)nxt.pn * tstep : cB;
        for (int t = 0; t < nt; t += 2) {
            const bool last = (t == nt - 2);
            const char* a1 = cA + (size_t)(t + 1) * kstep;
            const char* a2 = last ? nA : cA + (size_t)(t + 2) * kstep; const char* b2 = last ? nB : cB + (size_t)(t + 2) * kstep;
            const char* a3 = a2 + kstep; const char* b3 = b2 + kstep;
            if (last && has_next) S.a_ready(nxt);
            if constexpr (SP2) {
            PG8_LDB(B0, 0, 0); PG8_LDB(B1, 0, 1); PG8_SCHED; PG8_LDA(At, 0, 0); PG8_STAGE(PG8_SA(1, 1), a1 + hstep, voffA);
            PG8_WAIT_V(8); PG8_WAIT_L(0); PG8_BAR; PG8_MMA(0, 0, At, B0); PG8_MMA(0, 1, At, B1); PG8_BAR; PG8_SCHED;
            PG8_LDA(At, 0, 1); PG8_STAGE(PG8_SB(0, 0), b2, voffB); PG8_STAGE(PG8_SB(0, 1), b2 + hstep, voffB); PG8_STAGE(PG8_SA(0, 0), a2, voffA);
            PG8_WAIT_V(8); PG8_WAIT_L(0); PG8_BAR; PG8_MMA(1, 0, At, B0); PG8_MMA(1, 1, At, B1); PG8_BAR; PG8_SCHED;
            PG8_LDB(B0, 1, 0); PG8_LDB(B1, 1, 1); PG8_SCHED; PG8_LDA(At, 1, 0); PG8_STAGE(PG8_SA(0, 1), a2 + hstep, voffA);
            PG8_WAIT_V(8); PG8_WAIT_L(0); PG8_BAR; PG8_MMA(0, 0, At, B0); PG8_MMA(0, 1, At, B1); PG8_BAR; PG8_SCHED;
            PG8_LDA(At, 1, 1); PG8_STAGE(PG8_SB(1, 0), b3, voffB); PG8_STAGE(PG8_SB(1, 1), b3 + hstep, voffB); PG8_STAGE(PG8_SA(1, 0), a3, voffA);
            PG8_WAIT_V(8); PG8_WAIT_L(0); PG8_BAR; PG8_MMA(1, 0, At, B0); PG8_MMA(1, 1, At, B1); PG8_BAR; PG8_SCHED;
            } else {
            PG8_LDB(B0, 0, 0); PG8_SCHED; PG8_LDA(At, 0, 0); PG8_STAGE(PG8_SA(1, 1), a1 + hstep, voffA);
            PG8_WAIT_L(8); PG8_BAR; PG8_WAIT_L(0); PG8_MMA(0, 0, At, B0); PG8_BAR; PG8_SCHED;
            PG8_LDB(B1, 0, 1); PG8_STAGE(PG8_SB(0, 0), b2, voffB);
            PG8_BAR; PG8_WAIT_L(0); PG8_MMA(0, 1, At, B1); PG8_BAR;
            PG8_LDA(At, 0, 1); PG8_STAGE(PG8_SA(0, 0), a2, voffA);
            PG8_BAR; PG8_WAIT_L(0); PG8_MMA(1, 0, At, B0); PG8_BAR; PG8_SCHED;
            PG8_STAGE(PG8_SB(0, 1), b2 + hstep, voffB);
            PG8_WAIT_V(6); PG8_BAR; PG8_MMA(1, 1, At, B1); PG8_BAR;
            PG8_LDB(B0, 1, 0); PG8_SCHED; PG8_LDA(At, 1, 0); PG8_STAGE(PG8_SA(0, 1), a2 + hstep, voffA);
            PG8_WAIT_L(8); PG8_BAR; PG8_WAIT_L(0); PG8_MMA(0, 0, At, B0); PG8_BAR; PG8_SCHED;
            PG8_LDB(B1, 1, 1); PG8_STAGE(PG8_SB(1, 0), b3, voffB);
            PG8_BAR; PG8_WAIT_L(0); PG8_MMA(0, 1, At, B1); PG8_BAR;
            PG8_LDA(At, 1, 1); PG8_STAGE(PG8_SA(1, 0), a3, voffA);
            PG8_BAR; PG8_WAIT_L(0); PG8_MMA(1, 0, At, B0); PG8_BAR; PG8_SCHED;
            PG8_STAGE(PG8_SB(1, 1), b3 + hstep, voffB);
            PG8_WAIT_V(6); PG8_BAR; PG8_MMA(1, 1, At, B1); PG8_BAR;
            }
        }
        if constexpr (ALIGN_EPI) { if (wr == 0) PG8_BAR; }
        if constexpr (!Epi::AFTER_DRAIN) { E(acc, cur, wr, wc, fr, fq); S.done(cur); }
        if (!has_next) break;
#pragma unroll
        for (int a = 0; a < 2; ++a)
#pragma unroll
            for (int b = 0; b < 2; ++b)
#pragma unroll
                for (int m = 0; m < 4; ++m)
#pragma unroll
                    for (int n = 0; n < 2; ++n) acc[a][b][m][n] = (f32x4){0.f, 0.f, 0.f, 0.f};
        cur = nxt; cA = nA; cB = nB; ++ui;
        if constexpr (ALIGN_EPI) { if (wr == 1) PG8_BAR; }
    }
    PG8_WAIT_V(0);
    if constexpr (!ALIGN_EPI) { if (wr == 0) PG8_BAR; }
    PG8_BAR;
    if constexpr (Epi::AFTER_DRAIN) { E.fused(acc, cur, wr, wc, fr, fq, lds, wid, lane); S.done(cur); }
#undef PG8_SA
#undef PG8_SB
#undef PG8_STAGE
#undef PG8_LDA
#undef PG8_LDB
#undef PG8_MMA
#undef PG8_WAIT_V
#undef PG8_WAIT_L
#undef PG8_BAR
#undef PG8_SCHED
}
}
constexpr int D = 2048, BATCH = 4, SEQ = 2048, M = BATCH * SEQ, DFF = 5632;
constexpr int A_H = 8, A_DV = 256, A_DQK = 128, A_L = 64, A_NC = SEQ / A_L, A_INC = 6160;
constexpr int B_H = 16, B_DH = 128;
constexpr float EPS = 1e-6f, LOG2E = 1.4426950408889634f;
constexpr int NWAVES = 8;

constexpr size_t MiB = 1u << 20;
constexpr size_t WS_CTL = 0, CTL_BYTES = 1 * MiB;
constexpr size_t WS_WG = 1 * MiB;
constexpr size_t WS_GATES = 2 * MiB;
constexpr size_t WS_DN = 3 * MiB;
constexpr size_t WS_KPART = 3 * MiB + 512 * 1024;
constexpr size_t WS_FFN = 4 * MiB;
constexpr size_t W1_BYTES = 44 * MiB, FFN_BYTES = 66 * MiB;
constexpr size_t WS_AW = WS_FFN + 8 * FFN_BYTES;
constexpr size_t WS_KVK = WS_AW + 64 * MiB, WS_KVV = WS_KVK + 8 * MiB;
constexpr size_t WS_BQ = WS_KVV + 8 * MiB, WS_BO = WS_BQ + 16 * MiB;
constexpr size_t WS_X = WS_BO + 16 * MiB;
constexpr size_t WS_XN = WS_X + 64 * MiB;
constexpr size_t WS_KB = WS_XN + 32 * MiB;
constexpr size_t WS_VTB = WS_KB + 32 * MiB;
constexpr size_t WS_SCR = WS_VTB + 32 * MiB;
constexpr size_t SCR_ACT = 0;
constexpr size_t SCR_PROJ = 0, SCR_VTA = 64 * MiB, SCR_HSNUM = 96 * MiB, SCR_HS = 160 * MiB;
constexpr size_t SCR_Q = 0, SCR_O = 32 * MiB;
constexpr size_t WS_END = WS_SCR + 256 * MiB;
constexpr int CW_BAR = 4096;

constexpr int LDS_BYTES = 147456;
constexpr int LDSCTL_OFF = 143360;
constexpr int JOBS_OFF = LDSCTL_OFF + 64;

#define GAS __attribute__((address_space(1)))
#define LAS __attribute__((address_space(3)))
typedef unsigned short bf16;
typedef unsigned v4u __attribute__((ext_vector_type(4)));
typedef unsigned v2u __attribute__((ext_vector_type(2)));
typedef float f32x4 __attribute__((ext_vector_type(4)));
typedef float f32x2 __attribute__((ext_vector_type(2)));
typedef short bf16x8 __attribute__((ext_vector_type(8)));
typedef __bf16 nbf16x2 __attribute__((ext_vector_type(2)));
#define LDS_WAIT() asm volatile("s_waitcnt lgkmcnt(0)" ::: "memory")
#define MFMA16(a, b, c) __builtin_amdgcn_mfma_f32_16x16x32_bf16((a), (b), (c), 0, 0, 0)
__device__ __forceinline__ unsigned pk2(float lo, float hi) { f32x2 v = {lo, hi}; return __builtin_bit_cast(unsigned, __builtin_convertvector(v, nbf16x2)); }
__device__ __forceinline__ float bflo(unsigned w) { return __builtin_bit_cast(float, w << 16); }
__device__ __forceinline__ float bfhi(unsigned w) { return __builtin_bit_cast(float, w & 0xffff0000u); }
__device__ __forceinline__ float wave_sum(float v) {
#pragma unroll
    for (int o = 1; o < 64; o <<= 1) v += __shfl_xor(v, o);
    return v;
}
#define PHASE_IDS int tid = threadIdx.x; asm volatile("" : "+v"(tid)); const int lane = tid & 63, wave = __builtin_amdgcn_readfirstlane(tid >> 6); \
    const int G = gridDim.x, vcu = (G % 8 == 0) ? ((int)blockIdx.x % 8) * (G / 8) + (int)blockIdx.x / 8 : (int)blockIdx.x; (void)lane; (void)wave; (void)vcu; (void)G;
#define XB_TMO      128
#define XB_XCNT(j)  (256  + 64 * (j))
#define XB_XSUB(j)  (1280 + 64 * (j))
#define XB_XGEN(j)  (2304 + 64 * (j))
#define XB_TOP      3328
#define XB_TOPGEN   3392
#define XCD_BAR_WORDS 3456
#define XB_SPIN_CAP (1u << 18)
#define LAS __attribute__((address_space(3)))

__device__ __forceinline__ unsigned xb_ld(unsigned* p)              { return __hip_atomic_load(p, __ATOMIC_RELAXED, __HIP_MEMORY_SCOPE_AGENT); }
__device__ __forceinline__ unsigned xb_add(unsigned* p, unsigned v) { return __hip_atomic_fetch_add(p, v, __ATOMIC_RELAXED, __HIP_MEMORY_SCOPE_AGENT); }
__device__ __forceinline__ unsigned xb_xcc_id() { return (unsigned)__builtin_amdgcn_s_getreg((3 << 11) | 20) & 0xFu; }
#define XB_SPIN(cond, bar) do { unsigned _sp = 0; while (cond) { __builtin_amdgcn_s_sleep(1); \
    if ((++_sp & 255u) == 0u) { if (xb_ld(&(bar)[XB_TMO])) break; if (_sp > XB_SPIN_CAP) { atomicAdd(&(bar)[XB_TMO], 1u); break; } } } } while (0)

struct XcdBarrier {
    unsigned* bar; unsigned x;
    volatile LAS unsigned* st;
};

__device__ __forceinline__ XcdBarrier xcd_barrier_post(unsigned* bar, volatile LAS unsigned* st) {
    XcdBarrier b; b.bar = bar; b.x = xb_xcc_id(); b.st = st;
    if (threadIdx.x == 0) (void)xb_add(&bar[XB_XCNT(b.x)], 1u);
    return b;
}
__device__ __forceinline__ void xcd_barrier_complete(unsigned* bar, unsigned x, unsigned& nloc, unsigned& nx) {
    const unsigned G = gridDim.x * gridDim.y * gridDim.z;
    unsigned sum, cnt, mine, sp = 0u;
    for (;;) {
        sum = 0u; cnt = 0u; mine = 0u;
#pragma unroll
        for (unsigned j = 0; j < 16; ++j) { const unsigned c = xb_ld(&bar[XB_XCNT(j)]); sum += c; cnt += (c > 0u) ? 1u : 0u; mine = (j == x) ? c : mine; }
        if (sum == G) break;
        __builtin_amdgcn_s_sleep(1);
        if ((++sp & 255u) == 0u) { if (xb_ld(&bar[XB_TMO])) break; if (sp > XB_SPIN_CAP) { atomicAdd(&bar[XB_TMO], 1u); break; } }
    }
    nloc = mine > 0u ? mine : 1u; nx = cnt > 0u ? cnt : 1u;
}

__device__ __forceinline__ void xcd_barrier(const XcdBarrier& b) {
    asm volatile("s_waitcnt vmcnt(0)" ::: "memory");
    __syncthreads();
    if (threadIdx.x == 0) {
        unsigned* bar = b.bar;
        __builtin_amdgcn_s_waitcnt(0);
        unsigned nloc = b.st[0], nx = b.st[1];
        if (nloc == 0u) { xcd_barrier_complete(bar, b.x, nloc, nx); b.st[0] = nloc; b.st[1] = nx; }
        const unsigned old = xb_add(&bar[XB_XSUB(b.x)], 1u);
        const unsigned gen = old / nloc;
        if (old + 1u == (gen + 1u) * nloc) {
            __builtin_amdgcn_fence(__ATOMIC_RELEASE, "agent");
            asm volatile("s_waitcnt vmcnt(0)" ::: "memory");
            const unsigned og = xb_add(&bar[XB_TOP], 1u);
            const unsigned tg = og / nx;
            if (og + 1u == (tg + 1u) * nx) xb_add(&bar[XB_TOPGEN], 1u);
            else XB_SPIN(xb_ld(&bar[XB_TOPGEN]) == tg, bar);
            __builtin_amdgcn_fence(__ATOMIC_ACQUIRE, "agent");
            xb_add(&bar[XB_XGEN(b.x)], 1u);
            asm volatile("s_waitcnt vmcnt(0)" ::: "memory");
        } else {
            XB_SPIN(xb_ld(&bar[XB_XGEN(b.x)]) == gen, bar);
            __builtin_amdgcn_fence(__ATOMIC_ACQUIRE, "agent");
            asm volatile("s_waitcnt vmcnt(0)" ::: "memory");
        }
    }
    __syncthreads();
}
struct Frame { LAS unsigned char* lds; };

struct Job { const float* src; bf16* dst; int ldw, K, c0, nblk, perm, start; };
__device__ __forceinline__ void put_job(LAS Job* J, int& nj, int& start, const float* src, bf16* dst, int ldw, int K, int c0, int ncols, int perm) {
    J[nj].src = src; J[nj].dst = dst; J[nj].ldw = ldw; J[nj].K = K; J[nj].c0 = c0; J[nj].nblk = ncols / 64; J[nj].perm = perm; J[nj].start = start;
    start += (K / 64) * (ncols / 64); ++nj;
}
struct Ptrs {
    const float* in[17]; float* out; unsigned char* ws;
};
typedef const __attribute__((address_space(4))) Ptrs* KArgs;
struct CvtItem { const GAS float* src; GAS bf16* dst; int ldw, K; };
__device__ __forceinline__ bool cvt_get(LAS Job* J, int nj, int total, int it, int& j, CvtItem& d) {
    if (it >= total) return false;
    while (j + 1 < nj && it >= J[j + 1].start) ++j;
    const int local = it - J[j].start, nblk = J[j].nblk, nb = local % nblk, kb = local / nblk, n0 = 64 * nb, K = J[j].K, ldw = J[j].ldw;
    int sc = n0;
    if (J[j].perm) { const int t = n0 >> 8, c = n0 & 255; sc = (c < 128) ? (128 * t + c) : (DFF + 128 * t + (c - 128)); }
    d.src = (const GAS float*)J[j].src + (size_t)(64 * kb) * ldw + J[j].c0 + sc; d.dst = (GAS bf16*)J[j].dst + (size_t)n0 * K + 64 * kb; d.ldw = ldw; d.K = K;
    return true;
}
__device__ __forceinline__ void cvt_load(f32x4 (&v)[16], const CvtItem& d, int lane) {
    const GAS float* p = d.src + (size_t)(lane >> 4) * d.ldw + 4 * (lane & 15);
#pragma unroll
    for (int i = 0; i < 16; ++i) v[i] = __builtin_nontemporal_load((const GAS f32x4*)(p + (size_t)(4 * i) * d.ldw));
}
__device__ __forceinline__ void cvt_proc(const f32x4 (&v)[16], const CvtItem& d, LAS float* scr, int lane) {
#pragma unroll
    for (int i = 0; i < 16; ++i) { const int k = 4 * i + (lane >> 4), pcg = (lane & 15) ^ ((k >> 3) & 7); *(LAS f32x4*)(scr + k * 64 + 4 * pcg) = v[i]; }
    LDS_WAIT();
    const int c = lane & 7;
#pragma unroll
    for (int j = 0; j < 8; ++j) { const int nrow = (lane >> 3) + 8 * j; const LAS float* s = scr + (8 * c) * 64 + 4 * ((nrow >> 2) ^ c) + (nrow & 3);
        v4u o; o.x = pk2(s[0 * 64], s[1 * 64]); o.y = pk2(s[2 * 64], s[3 * 64]); o.z = pk2(s[4 * 64], s[5 * 64]); o.w = pk2(s[6 * 64], s[7 * 64]);
        *(GAS v4u*)(d.dst + (size_t)nrow * d.K + 8 * c) = o; }
    LDS_WAIT();
}
#ifndef CVT_QT
#define CVT_QT 5120
#endif
#ifndef CVT_QM
#define CVT_QM 16384
#endif
constexpr int IT_FFN = 8448, IT_ML = 4096, IT_KV = 2048, IT_AT = 2048, IT_TOTAL = 81920;
__host__ __device__ constexpr int stage_sb(int st) { return st < 6 ? st : st - 1; }
__host__ __device__ constexpr int stage_kind(int st) { return st == 6 ? 3 : (stage_sb(st) % 3 != 1) ? 0 : (stage_sb(st) / 3 < 2 ? 1 : 2); }
__host__ __device__ constexpr int stage_items(int st) { return stage_kind(st) == 0 ? IT_FFN : stage_kind(st) == 1 ? IT_ML : stage_kind(st) == 2 ? IT_AT : IT_KV; }
__host__ __device__ constexpr int need_end(int st) { int s = 0; for (int i = 0; i <= st; ++i) s += stage_items(i); return s; }
__host__ __device__ constexpr int slots_before(int st) { int s = 0; for (int i = 0; i < st; ++i) s += stage_kind(i) == 0 ? CVT_QT : stage_kind(i) == 1 ? CVT_QM : 0; return s; }
__host__ __device__ constexpr int upfront_items() { int u = need_end(0); for (int st = 1; st < 13; ++st) { const int r = need_end(st) - slots_before(st); if (r > u) u = r; } return u > IT_TOTAL ? IT_TOTAL : u; }
constexpr int CVT_UPFRONT = upfront_items();
static_assert(need_end(12) == IT_TOTAL, "conversion item count");
__device__ __forceinline__ void jobs_init(const Frame& F, KArgs Pp) {
#define P (*Pp)
    LAS Job* J = (LAS Job*)(F.lds + JOBS_OFF);
    LAS int* JN = (LAS int*)(F.lds + JOBS_OFF + 40 * 40);
    if (threadIdx.x == 0) {
        int nj = 0, start = 0; unsigned char* ws = P.ws;
        for (int st = 0; st < 13; ++st) { const int sb = stage_sb(st), l = sb / 3, ty = sb % 3, kind = stage_kind(st);
            if (kind == 0) { const int which = (ty == 2), f = 2 * l + which;
                const float* win = (which ? P.in[6] : P.in[2]) + (size_t)l * D * (2 * DFF);
                const float* wout = (which ? P.in[7] : P.in[3]) + (size_t)l * DFF * D;
                put_job(J, nj, start, win, (bf16*)(ws + WS_FFN + f * FFN_BYTES), 2 * DFF, D, 0, 2 * DFF, 1);
                put_job(J, nj, start, wout, (bf16*)(ws + WS_FFN + f * FFN_BYTES + W1_BYTES), D, DFF, 0, D, 0); }
            else if (kind == 1) { const float* w = P.in[8] + (size_t)l * D * A_INC; unsigned char* base = ws + WS_AW + (size_t)l * 32 * MiB;
                put_job(J, nj, start, w, (bf16*)base, A_INC, D, 0, 2048, 0);
                put_job(J, nj, start, w, (bf16*)base + (size_t)2048 * D, A_INC, D, 4096, 2048, 0);
                put_job(J, nj, start, w, (bf16*)(base + 16 * MiB), A_INC, D, 2048, 2048, 0);
                put_job(J, nj, start, P.in[11] + (size_t)l * D * D, (bf16*)(base + 24 * MiB), D, D, 0, D, 0); }
            else if (kind == 3) {
                put_job(J, nj, start, P.in[13], (bf16*)(ws + WS_KVK), 2 * D, D, 0, D, 0);
                put_job(J, nj, start, P.in[13], (bf16*)(ws + WS_KVV), 2 * D, D, D, D, 0); }
            else { const int j = l - 2;
                put_job(J, nj, start, P.in[14] + (size_t)j * D * D, (bf16*)(ws + WS_BQ + (size_t)j * 8 * MiB), D, D, 0, D, 0);
                put_job(J, nj, start, P.in[15] + (size_t)j * D * D, (bf16*)(ws + WS_BO + (size_t)j * 8 * MiB), D, D, 0, D, 0); } }
        JN[0] = nj; JN[1] = start;
        J[nj].start = start;
    }
    __syncthreads();
#undef P
}
__device__ __forceinline__ void convert_range(const Frame& F, int lo, int hi, int widx, int nw) {
    int tid = threadIdx.x; asm volatile("" : "+v"(tid)); const int lane = tid & 63, wave = __builtin_amdgcn_readfirstlane(tid >> 6);
    LAS Job* J = (LAS Job*)(F.lds + JOBS_OFF);
    const int nj = ((LAS int*)(F.lds + JOBS_OFF + 40 * 40))[0];
    if (hi > IT_TOTAL) hi = IT_TOTAL;
    LAS float* scr = (LAS float*)(F.lds + wave * 16384);
    int j = 0, it = lo + widx; f32x4 va[16], vb[16]; CvtItem da, db;
    bool ha = cvt_get(J, nj, hi, it, j, da); if (ha) cvt_load(va, da, lane);
    while (ha) {
        it += nw; const bool hb = cvt_get(J, nj, hi, it, j, db); if (hb) cvt_load(vb, db, lane);
        cvt_proc(va, da, scr, lane);
        if (!hb) break;
        it += nw; ha = cvt_get(J, nj, hi, it, j, da); if (ha) cvt_load(va, da, lane);
        cvt_proc(vb, db, scr, lane);
    }
}
__device__ __forceinline__ void convert_slot(const Frame& F, int st) {
    int nT = 0, nM = 0;
    for (int i = 0; i < st; ++i) { const int k = stage_kind(i); nT += (k == 0); nM += (k == 1); }
    const int lo = CVT_UPFRONT + nT * CVT_QT + nM * CVT_QM, hi = lo + (stage_kind(st) == 0 ? CVT_QT : CVT_QM);
    if (lo < IT_TOTAL) convert_range(F, lo, hi, ((int)blockIdx.x - 128) * NWAVES + __builtin_amdgcn_readfirstlane((int)threadIdx.x >> 6), 128 * NWAVES);
}
__device__ __forceinline__ void p0_convert(const Frame& F, KArgs Pp) {
#define P (*Pp)
    PHASE_IDS
    convert_range(F, 0, CVT_UPFRONT, vcu * NWAVES + wave, G * NWAVES);
    { float* wg = (float*)(P.ws + WS_WG);
      for (int i = (vcu * NWAVES + wave) * 64 + lane; i < 2 * D * 16; i += G * NWAVES * 64) { const int l = i >> 15, k = (i >> 4) & (D - 1), jj = i & 15;
          wg[i] = P.in[8][(size_t)l * D * A_INC + (size_t)k * A_INC + 6144 + jj]; } }
    __syncthreads();
#undef P
}

__device__ __forceinline__ void norm_phase(const Frame& F, const float* xin, const float* gain, bf16* xn, bool gates, const float* wg, const float* bg, float* gout) {
    PHASE_IDS
    const int gw = vcu * NWAVES + wave, NGW = G * NWAVES;
    if (gates) {
        for (int e = tid; e < D * 4; e += NWAVES * 64) { const int k = e >> 2, q = e & 3, j = k >> 8, ln = (k & 255) >> 2, c = k & 3;
            *(LAS f32x4*)(F.lds + ((((j * 4 + c) * 4 + q) * 64 + ln) << 4)) = *(const f32x4*)(wg + (size_t)e * 4); }
        LDS_WAIT(); __syncthreads();
    }
    f32x4 gv[8];
#pragma unroll
    for (int j = 0; j < 8; ++j) gv[j] = *(const f32x4*)(gain + 256 * j + 4 * lane);
    for (int m = gw; m < M; m += NGW) {
        const f32x4* xr = (const f32x4*)(xin + (size_t)m * D) + lane;
        f32x4 v[8]; float s = 0.f;
#pragma unroll
        for (int j = 0; j < 8; ++j) { v[j] = xr[64 * j]; s += (v[j].x * v[j].x + v[j].y * v[j].y) + (v[j].z * v[j].z + v[j].w * v[j].w); }
        const float rstd = 1.0f / sqrtf(wave_sum(s) * (1.0f / D) + EPS);
        v2u* o8 = (v2u*)(xn + (size_t)m * D) + lane;
#pragma unroll
        for (int j = 0; j < 8; ++j) { v[j] = v[j] * rstd * gv[j]; v2u w; w.x = pk2(v[j].x, v[j].y); w.y = pk2(v[j].z, v[j].w); o8[64 * j] = w; }
        if (gates) {
            float acc[16];
#pragma unroll
            for (int q = 0; q < 16; ++q) acc[q] = 0.f;
#pragma unroll
            for (int j = 0; j < 8; ++j)
#pragma unroll
                for (int c = 0; c < 4; ++c) { const LAS f32x4* wp = (const LAS f32x4*)(F.lds + (((j * 4 + c) * 4 * 64 + lane) << 4)); const float y = v[j][c];
                    const f32x4 w0 = wp[0], w1 = wp[64], w2 = wp[128], w3 = wp[192];
                    acc[0] += y * w0.x; acc[1] += y * w0.y; acc[2] += y * w0.z; acc[3] += y * w0.w; acc[4] += y * w1.x; acc[5] += y * w1.y; acc[6] += y * w1.z; acc[7] += y * w1.w;
                    acc[8] += y * w2.x; acc[9] += y * w2.y; acc[10] += y * w2.z; acc[11] += y * w2.w; acc[12] += y * w3.x; acc[13] += y * w3.y; acc[14] += y * w3.z; acc[15] += y * w3.w; }
            float r8[8], r4[4], r2[2], r1;
            { const bool up = (lane & 32) != 0;
#pragma unroll
              for (int i = 0; i < 8; ++i) { const float keep = up ? acc[i + 8] : acc[i], send = up ? acc[i] : acc[i + 8]; r8[i] = keep + __shfl_xor(send, 32); } }
            { const bool up = (lane & 16) != 0;
#pragma unroll
              for (int i = 0; i < 4; ++i) { const float keep = up ? r8[i + 4] : r8[i], send = up ? r8[i] : r8[i + 4]; r4[i] = keep + __shfl_xor(send, 16); } }
            { const bool up = (lane & 8) != 0;
#pragma unroll
              for (int i = 0; i < 2; ++i) { const float keep = up ? r4[i + 2] : r4[i], send = up ? r4[i] : r4[i + 2]; r2[i] = keep + __shfl_xor(send, 8); } }
            { const bool up = (lane & 4) != 0; const float keep = up ? r2[1] : r2[0], send = up ? r2[0] : r2[1]; r1 = keep + __shfl_xor(send, 4); }
            r1 += __shfl_xor(r1, 1); r1 += __shfl_xor(r1, 2);
            if ((lane & 3) == 0) { const int jj = ((lane >> 5) & 1) * 8 + ((lane >> 4) & 1) * 4 + ((lane >> 3) & 1) * 2 + ((lane >> 2) & 1);
                const float gpre = r1 + bg[jj]; float val;
                if (jj < 8) val = 15.0f * tanhf(gpre * (1.0f / 15.0f));
                else val = fminf(gpre, 0.f) - log1pf(expf(-fabsf(gpre)));
                gout[(size_t)m * 16 + jj] = val; }
        }
    }
    if (gates) { LDS_WAIT(); __syncthreads(); }
}
__device__ __forceinline__ void final_norm_phase(const Frame& F, const float* xin, const float* gain, float* out) {
    PHASE_IDS
    const int gw = vcu * NWAVES + wave, NGW = G * NWAVES;
    f32x4 gv[8];
#pragma unroll
    for (int j = 0; j < 8; ++j) gv[j] = *(const f32x4*)(gain + 256 * j + 4 * lane);
    for (int m = gw; m < M; m += NGW) {
        const f32x4* xr = (const f32x4*)(xin + (size_t)m * D) + lane;
        f32x4 v[8]; float s = 0.f;
#pragma unroll
        for (int j = 0; j < 8; ++j) { v[j] = xr[64 * j]; s += (v[j].x * v[j].x + v[j].y * v[j].y) + (v[j].z * v[j].z + v[j].w * v[j].w); }
        const float rstd = 1.0f / sqrtf(wave_sum(s) * (1.0f / D) + EPS);
        f32x4* o = (f32x4*)(out + (size_t)m * D) + lane;
#pragma unroll
        for (int j = 0; j < 8; ++j) o[64 * j] = v[j] * rstd * gv[j];
    }
}
__device__ __forceinline__ void mlstm_finalize_phase(const Frame& F, const float* num, const float* dn, const bf16* proj, const float* hgain, bf16* hs) {
    PHASE_IDS
    const int gw = vcu * NWAVES + wave, NGW = G * NWAVES;
    for (int m = gw; m < M; m += NGW) {
#pragma unroll
        for (int h = 0; h < A_H; ++h) {
            const f32x4 nv = *(const f32x4*)(num + (size_t)m * 2048 + h * 256 + 4 * lane);
            const float rd = 1.0f / dn[(size_t)m * 8 + h];
            const f32x4 hv = nv * rd;
            const float ss = wave_sum((hv.x * hv.x + hv.y * hv.y) + (hv.z * hv.z + hv.w * hv.w));
            const float r = 1.0f / sqrtf(ss * (1.0f / 256.0f) + EPS);
            const f32x4 g = *(const f32x4*)(hgain + h * 256 + 4 * lane);
            const v2u ogw = *(const v2u*)(proj + (size_t)m * 4096 + 2048 + h * 256 + 4 * lane);
            const float o0 = bflo(ogw.x), o1 = bfhi(ogw.x), o2 = bflo(ogw.y), o3 = bfhi(ogw.y);
            const float y0 = hv.x * r * g.x / (1.0f + __expf(-o0)), y1 = hv.y * r * g.y / (1.0f + __expf(-o1));
            const float y2 = hv.z * r * g.z / (1.0f + __expf(-o2)), y3 = hv.w * r * g.w / (1.0f + __expf(-o3));
            v2u w; w.x = pk2(y0, y1); w.y = pk2(y2, y3);
            *(v2u*)(hs + (size_t)m * 2048 + h * 256 + 4 * lane) = w;
        }
    }
}
constexpr int ML_QS = 272, ML_TS = 144;
constexpr int ML_Q0 = 0, ML_K0 = 34816, ML_KT0 = 69632, ML_VT0 = 106496, ML_SW = 124928, ML_SC0 = 134144, ML_END = 137216;
constexpr int ML_QB = 17408, ML_KTB = 18432, ML_VTB = 9216, ML_SCB = 1536;
constexpr int SC_A2 = 0, SC_U2 = 256, SC_DEC = 512, SC_W = 768, SC_FLOOR = 1024, SC_CDEC = 1280;
static_assert(ML_END <= LDSCTL_OFF, "mLSTM LDS map");

__device__ __forceinline__ float scan_add(float x, int lane) {
#pragma unroll
    for (int o = 1; o < 64; o <<= 1) { const float y = __shfl_up(x, o); if (lane >= o) x += y; }
    return x;
}
__device__ __forceinline__ float scan_max(float x, int lane) {
#pragma unroll
    for (int o = 1; o < 64; o <<= 1) { const float y = __shfl_up(x, o); if (lane >= o) x = fmaxf(x, y); }
    return x;
}
__device__ __forceinline__ float mlstm_scalars(LAS unsigned char* sc, const float* gates, int tok0, int h, int lane, float m) {
    const float ig = gates[(size_t)(tok0 + lane) * 16 + h], lf = gates[(size_t)(tok0 + lane) * 16 + 8 + h];
    const float b = scan_add(lf, lane);
    const float u = ig - b;
    const float pm = scan_max(u, lane);
    const float mx = fmaxf(pm, m);
    const float a63 = -__shfl(mx, 63), b63 = __shfl(b, 63);
    ((LAS float*)(sc + SC_A2))[lane] = -mx * LOG2E;
    ((LAS float*)(sc + SC_U2))[lane] = u * LOG2E;
    ((LAS float*)(sc + SC_DEC))[lane] = __expf(m - mx);
    ((LAS float*)(sc + SC_W))[lane] = __expf(u + a63);
    ((LAS float*)(sc + SC_FLOOR))[lane] = __expf(-(b + mx));
    if (lane == 0) ((LAS float*)(sc + SC_CDEC))[0] = __expf(m + a63);
    return b63 - a63;
}
__device__ __forceinline__ void mlstm_phase(const Frame& F, const bf16* proj, const bf16* vta, const float* gates, float* hsnum, float* dnbuf, int st) {
    if (blockIdx.x >= 128) { convert_slot(F, st); return; }
    PHASE_IDS
    LAS unsigned char* lds = F.lds;
    const int w = wave, l15 = lane & 15, g = lane >> 4;
    const int unit = blockIdx.x, bh = unit >> 2, vs = unit & 3, b = bh >> 3, h = bh & 7;
    const int tokb = b * SEQ;
    const int qrow0 = tid >> 4, qc16 = tid & 15;
    const int vrow_p = tid >> 3, vc16 = tid & 7;
    const bf16* qg = proj + (size_t)(tokb + qrow0) * 4096 + h * 128 + qc16 * 8;
    const bf16* vg = vta + (size_t)(h * 256 + vs * 64 + vrow_p) * M + tokb + vc16 * 8;
    v4u rq[2], rk[2], rv;
#define ML_LOAD(c) do { const size_t _t = (size_t)(c) * A_L; \
        rq[0] = *(const v4u*)(qg + _t * 4096); rq[1] = *(const v4u*)(qg + (_t + 32) * 4096); \
        rk[0] = *(const v4u*)(qg + _t * 4096 + 1024); rk[1] = *(const v4u*)(qg + (_t + 32) * 4096 + 1024); \
        rv = *(const v4u*)(vg + _t); } while (0)
#define ML_STORE(bufi) do { \
        _Pragma("unroll") for (int _i = 0; _i < 2; ++_i) { const int _row = qrow0 + 32 * _i; \
            *(LAS v4u*)(lds + ML_Q0 + (bufi) * ML_QB + _row * ML_QS + qc16 * 16) = rq[_i]; \
            *(LAS v4u*)(lds + ML_K0 + (bufi) * ML_QB + _row * ML_QS + qc16 * 16) = rk[_i]; \
            LAS unsigned char* _kt = lds + ML_KT0 + (bufi) * ML_KTB + (qc16 * 8) * ML_TS + _row * 2; \
            *(LAS bf16*)(_kt + 0 * ML_TS) = (bf16)(rk[_i].x & 0xffffu); *(LAS bf16*)(_kt + 1 * ML_TS) = (bf16)(rk[_i].x >> 16); \
            *(LAS bf16*)(_kt + 2 * ML_TS) = (bf16)(rk[_i].y & 0xffffu); *(LAS bf16*)(_kt + 3 * ML_TS) = (bf16)(rk[_i].y >> 16); \
            *(LAS bf16*)(_kt + 4 * ML_TS) = (bf16)(rk[_i].z & 0xffffu); *(LAS bf16*)(_kt + 5 * ML_TS) = (bf16)(rk[_i].z >> 16); \
            *(LAS bf16*)(_kt + 6 * ML_TS) = (bf16)(rk[_i].w & 0xffffu); *(LAS bf16*)(_kt + 7 * ML_TS) = (bf16)(rk[_i].w >> 16); } \
        *(LAS v4u*)(lds + ML_VT0 + (bufi) * ML_VTB + vrow_p * ML_TS + vc16 * 16) = rv; } while (0)
    float mrun = 0.f;
    ML_LOAD(0); ML_STORE(0);
    if (w == 5) mrun = mlstm_scalars(lds + ML_SC0, gates, tokb, h, lane, mrun);
    f32x4 CT[8];
#pragma unroll
    for (int i = 0; i < 8; ++i) CT[i] = (f32x4){0.f, 0.f, 0.f, 0.f};
    const bool aux = (w == 4);
    const int vrow = 16 * (w & 3) + l15;
    LDS_WAIT(); __syncthreads();
    for (int c = 0; c < A_NC; ++c) {
        const int bf = c & 1, tok0 = tokb + c * A_L;
        LAS unsigned char* sQ = lds + ML_Q0 + bf * ML_QB; LAS unsigned char* sK = lds + ML_K0 + bf * ML_QB;
        LAS unsigned char* sKT = lds + ML_KT0 + bf * ML_KTB; LAS unsigned char* sVT = lds + ML_VT0 + bf * ML_VTB; LAS unsigned char* sSC = lds + ML_SC0 + bf * ML_SCB;
        if (c + 1 < A_NC) ML_LOAD(c + 1);
        { const int si = w & 3, tp = w >> 2;
          f32x4 sacc[2] = {(f32x4){0.f, 0.f, 0.f, 0.f}, (f32x4){0.f, 0.f, 0.f, 0.f}};
#pragma unroll
          for (int ks = 0; ks < 4; ++ks) { const bf16x8 a = *(const LAS bf16x8*)(sK + (16 * si + l15) * ML_QS + (32 * ks + 8 * g) * 2);
#pragma unroll
              for (int tt = 0; tt < 2; ++tt) { const bf16x8 bq = *(const LAS bf16x8*)(sQ + (16 * (2 * tp + tt) + l15) * ML_QS + (32 * ks + 8 * g) * 2); sacc[tt] = MFMA16(a, bq, sacc[tt]); } }
          const f32x4 u2 = *(const LAS f32x4*)(sSC + SC_U2 + (16 * si + 4 * g) * 4);
#pragma unroll
          for (int tt = 0; tt < 2; ++tt) { const int t = 16 * (2 * tp + tt) + l15; const float a2 = ((const LAS float*)(sSC + SC_A2))[t]; float e[4];
#pragma unroll
              for (int r = 0; r < 4; ++r) { const int s = 16 * si + 4 * g + r; const float x = sacc[tt][r] * __builtin_amdgcn_exp2f(a2 + u2[r]); e[r] = (s <= t) ? x : 0.f; }
              v2u pw; pw.x = pk2(e[0], e[1]); pw.y = pk2(e[2], e[3]);
              *(LAS v2u*)(lds + ML_SW + t * ML_TS + (16 * si + 4 * g) * 2) = pw; } }
        LDS_WAIT(); __syncthreads();
        if (w < 5) {
            f32x4 intra[4], inter[4];
#pragma unroll
            for (int i = 0; i < 4; ++i) { intra[i] = (f32x4){0.f, 0.f, 0.f, 0.f}; inter[i] = (f32x4){0.f, 0.f, 0.f, 0.f}; }
            const bf16x8 ones8 = (bf16x8){(short)0x3F80, (short)0x3F80, (short)0x3F80, (short)0x3F80, (short)0x3F80, (short)0x3F80, (short)0x3F80, (short)0x3F80};
            const bf16x8 zero8 = (bf16x8){0, 0, 0, 0, 0, 0, 0, 0};
            bf16x8 vraw[2];
#pragma unroll
            for (int ks = 0; ks < 2; ++ks) { vraw[ks] = *(const LAS bf16x8*)(sVT + vrow * ML_TS + (32 * ks + 8 * g) * 2);
                const bf16x8 bfrag = aux ? (l15 == 0 ? ones8 : zero8) : vraw[ks];
#pragma unroll
                for (int ti = 0; ti < 4; ++ti) { const bf16x8 af = *(const LAS bf16x8*)(lds + ML_SW + (16 * ti + l15) * ML_TS + (32 * ks + 8 * g) * 2); intra[ti] = MFMA16(af, bfrag, intra[ti]); } }
#pragma unroll
            for (int p = 0; p < 4; ++p) { v4u bw; bw.x = pk2(CT[2 * p][0], CT[2 * p][1]); bw.y = pk2(CT[2 * p][2], CT[2 * p][3]); bw.z = pk2(CT[2 * p + 1][0], CT[2 * p + 1][1]); bw.w = pk2(CT[2 * p + 1][2], CT[2 * p + 1][3]);
                const bf16x8 bfrag = __builtin_bit_cast(bf16x8, bw);
#pragma unroll
                for (int ti = 0; ti < 4; ++ti) { const v2u lo = *(const LAS v2u*)(sQ + (16 * ti + l15) * ML_QS + (32 * p + 4 * g) * 2), hi = *(const LAS v2u*)(sQ + (16 * ti + l15) * ML_QS + (32 * p + 16 + 4 * g) * 2);
                    v4u aw; aw.x = lo.x; aw.y = lo.y; aw.z = hi.x; aw.w = hi.y; inter[ti] = MFMA16(__builtin_bit_cast(bf16x8, aw), bfrag, inter[ti]); } }
#pragma unroll
            for (int ti = 0; ti < 4; ++ti) { const f32x4 dec4 = *(const LAS f32x4*)(sSC + SC_DEC + (16 * ti + 4 * g) * 4); const f32x4 nm = intra[ti] + dec4 * inter[ti];
                if (!aux) {
#pragma unroll
                    for (int r = 0; r < 4; ++r) hsnum[(size_t)(tok0 + 16 * ti + 4 * g + r) * 2048 + h * 256 + vs * 64 + vrow] = nm[r];
                } else if (l15 == 0 && vs == 0) { const f32x4 fl4 = *(const LAS f32x4*)(sSC + SC_FLOOR + (16 * ti + 4 * g) * 4);
#pragma unroll
                    for (int r = 0; r < 4; ++r) dnbuf[(size_t)(tok0 + 16 * ti + 4 * g + r) * 8 + h] = fmaxf(fabsf(nm[r]), fl4[r]); } }
            const float cdec = ((const LAS float*)(sSC + SC_CDEC))[0];
            bf16x8 bwv[2];
#pragma unroll
            for (int ks = 0; ks < 2; ++ks) { const f32x4 w0 = *(const LAS f32x4*)(sSC + SC_W + (32 * ks + 8 * g) * 4), w1 = *(const LAS f32x4*)(sSC + SC_W + (32 * ks + 8 * g + 4) * 4);
                const v4u raw = __builtin_bit_cast(v4u, vraw[ks]); v4u o;
                if (aux) { const bool on = (l15 == 0); o.x = on ? pk2(w0.x, w0.y) : 0u; o.y = on ? pk2(w0.z, w0.w) : 0u; o.z = on ? pk2(w1.x, w1.y) : 0u; o.w = on ? pk2(w1.z, w1.w) : 0u; }
                else { o.x = pk2(bflo(raw.x) * w0.x, bfhi(raw.x) * w0.y); o.y = pk2(bflo(raw.y) * w0.z, bfhi(raw.y) * w0.w); o.z = pk2(bflo(raw.z) * w1.x, bfhi(raw.z) * w1.y); o.w = pk2(bflo(raw.w) * w1.z, bfhi(raw.w) * w1.w); }
                bwv[ks] = __builtin_bit_cast(bf16x8, o); }
#pragma unroll
            for (int dt = 0; dt < 8; ++dt) { CT[dt] = CT[dt] * cdec;
#pragma unroll
                for (int ks = 0; ks < 2; ++ks) { const bf16x8 af = *(const LAS bf16x8*)(sKT + (16 * dt + l15) * ML_TS + (32 * ks + 8 * g) * 2); CT[dt] = MFMA16(af, bwv[ks], CT[dt]); } }
        } else if (w == 5) {
            if (c + 1 < A_NC) mrun = mlstm_scalars(lds + ML_SC0 + (bf ^ 1) * ML_SCB, gates, tok0 + A_L, h, lane, mrun);
        }
        if (c + 1 < A_NC) ML_STORE(bf ^ 1);
        LDS_WAIT(); __syncthreads();
    }
#undef ML_LOAD
#undef ML_STORE
}
constexpr int AT_KS = 272, AT_VS = 144, AT_KB = 17408, AT_VB = 18432, AT_K0 = 0, AT_V0 = 34816, AT_FLAGS = 71680, AT_END = 71680 + 64;
constexpr float AT_EXIT = 104.0f;
__device__ __forceinline__ void knorm_phase(const Frame& F, const bf16* KB, float* kpart) {
    PHASE_IDS
    const int gw = vcu * NWAVES + wave, NGW = G * NWAVES, g = lane >> 4;
    float wmax[4][4];
#pragma unroll
    for (int bb = 0; bb < 4; ++bb)
#pragma unroll
        for (int j = 0; j < 4; ++j) wmax[bb][j] = 0.f;
    for (int m = gw; m < M; m += NGW) {
        const int b = m >> 11;
#pragma unroll
        for (int j = 0; j < 4; ++j) { const v4u r = *(const v4u*)(KB + (size_t)m * 2048 + 8 * (lane + 64 * j));
            float s = bflo(r.x) * bflo(r.x) + bfhi(r.x) * bfhi(r.x) + bflo(r.y) * bflo(r.y) + bfhi(r.y) * bfhi(r.y) + bflo(r.z) * bflo(r.z) + bfhi(r.z) * bfhi(r.z) + bflo(r.w) * bflo(r.w) + bfhi(r.w) * bfhi(r.w);
            s += __shfl_xor(s, 1); s += __shfl_xor(s, 2); s += __shfl_xor(s, 4); s += __shfl_xor(s, 8);
#pragma unroll
            for (int bb = 0; bb < 4; ++bb) if (b == bb) wmax[bb][j] = fmaxf(wmax[bb][j], s); }
    }
    LAS float* tab = (LAS float*)F.lds;
    if ((lane & 15) == 0) {
#pragma unroll
        for (int bb = 0; bb < 4; ++bb)
#pragma unroll
            for (int j = 0; j < 4; ++j) tab[wave * 64 + bb * 16 + g + 4 * j] = wmax[bb][j];
    }
    LDS_WAIT(); __syncthreads();
    if (tid < 64) { float v = tab[tid];
#pragma unroll
        for (int ww = 1; ww < 8; ++ww) v = fmaxf(v, tab[ww * 64 + tid]);
        kpart[(size_t)blockIdx.x * 64 + tid] = v; }
    LDS_WAIT(); __syncthreads();
}
__device__ __forceinline__ void attn_phase(const Frame& F, const bf16* Q, const bf16* KB, const bf16* VT, bf16* O, const float* kpart) {
    PHASE_IDS
    LAS unsigned char* lds = F.lds;
    const int w = wave, l15 = lane & 15, g = lane >> 4;
    const int krow = tid >> 4, kc16 = tid & 15, vrow = tid >> 3, vc16 = tid & 7;
    for (int pp = blockIdx.x; pp < 512; pp += G) {
        const int bh = pp >> 3, ii = pp & 7, b = bh >> 4, h = bh & 15, tokb = b * SEQ;
        float kn2 = 0.f;
        for (int i = lane; i < G; i += 64) kn2 = fmaxf(kn2, kpart[(size_t)i * 64 + bh]);
#pragma unroll
        for (int o = 1; o < 64; o <<= 1) kn2 = fmaxf(kn2, __shfl_xor(kn2, o));
        const float kn = sqrtf(kn2) * 1.001f;
        for (int half = 0; half < 2; ++half) {
            const int qb = half ? (15 - ii) : ii, t0 = 128 * qb, tq0 = t0 + 16 * w, t = tq0 + l15;
            bf16x8 qf[4];
#pragma unroll
            for (int ks = 0; ks < 4; ++ks) qf[ks] = *(const bf16x8*)(Q + (size_t)(tokb + t) * 2048 + h * 128 + 32 * ks + 8 * g);
            float qn2 = 0.f;
#pragma unroll
            for (int ks = 0; ks < 4; ++ks) { const v4u r = __builtin_bit_cast(v4u, qf[ks]);
                qn2 += bflo(r.x) * bflo(r.x) + bfhi(r.x) * bfhi(r.x) + bflo(r.y) * bflo(r.y) + bfhi(r.y) * bfhi(r.y) + bflo(r.z) * bflo(r.z) + bfhi(r.z) * bfhi(r.z) + bflo(r.w) * bflo(r.w) + bfhi(r.w) * bfhi(r.w); }
            qn2 += __shfl_xor(qn2, 16); qn2 += __shfl_xor(qn2, 32);
            const float zb = sqrtf(qn2) * 1.001f * kn + AT_EXIT;
            f32x4 OT[8];
#pragma unroll
            for (int i = 0; i < 8; ++i) OT[i] = (f32x4){0.f, 0.f, 0.f, 0.f};
            float R = 0.f;
            const int nkb = 2 * qb + 2;
            const bf16* kg = KB + (size_t)(tokb + krow) * 2048 + h * 128 + kc16 * 8;
            const bf16* vg = VT + (size_t)(h * 128 + vrow) * M + tokb + vc16 * 8;
            v4u rk[2], rv[2];
#define AT_LOAD(kb) do { const size_t _s0 = (size_t)(kb) * 64; rk[0] = *(const v4u*)(kg + _s0 * 2048); rk[1] = *(const v4u*)(kg + (_s0 + 32) * 2048); \
                rv[0] = *(const v4u*)(vg + _s0); rv[1] = *(const v4u*)(vg + (size_t)64 * M + _s0); } while (0)
#define AT_STORE(bufi) do { *(LAS v4u*)(lds + AT_K0 + (bufi) * AT_KB + krow * AT_KS + kc16 * 16) = rk[0]; *(LAS v4u*)(lds + AT_K0 + (bufi) * AT_KB + (krow + 32) * AT_KS + kc16 * 16) = rk[1]; \
                *(LAS v4u*)(lds + AT_V0 + (bufi) * AT_VB + vrow * AT_VS + vc16 * 16) = rv[0]; *(LAS v4u*)(lds + AT_V0 + (bufi) * AT_VB + (vrow + 64) * AT_VS + vc16 * 16) = rv[1]; } while (0)
            AT_LOAD(nkb - 1); AT_STORE(0);
            if (lane == 0) { ((LAS unsigned*)(lds + AT_FLAGS))[w] = 0u; ((LAS unsigned*)(lds + AT_FLAGS))[8 + w] = 0u; }
            LDS_WAIT(); __syncthreads();
            bool wdone = false;
            for (int it = 0; it < nkb; ++it) {
                const int kb = nkb - 1 - it, bf = it & 1, s0 = 64 * kb;
                if (it + 1 < nkb) AT_LOAD(kb - 1);
                if (s0 <= tq0 && !wdone) {
                    LAS unsigned char* sK = lds + AT_K0 + bf * AT_KB; LAS unsigned char* sV = lds + AT_V0 + bf * AT_VB;
                    f32x4 z[4];
#pragma unroll
                    for (int si = 0; si < 4; ++si) { z[si] = (f32x4){0.f, 0.f, 0.f, 0.f};
#pragma unroll
                        for (int ks = 0; ks < 4; ++ks) { const bf16x8 a = *(const LAS bf16x8*)(sK + (16 * si + l15) * AT_KS + (32 * ks + 8 * g) * 2); z[si] = MFMA16(a, qf[ks], z[si]); } }
                    float L[4][4], P[4], tot[4], sufg[4];
#pragma unroll
                    for (int si = 0; si < 4; ++si) { P[si] = 0.f;
#pragma unroll
                        for (int r = 0; r < 4; ++r) { const int s = s0 + 16 * si + 4 * g + r; const float zz = z[si][r];
                            const float sp = fmaxf(zz, 0.f) + __logf(1.0f + __expf(-fabsf(zz)));
                            L[si][r] = (s < t) ? sp : 0.f; P[si] += L[si][r]; } }
#pragma unroll
                    for (int si = 0; si < 4; ++si) { const float a = __shfl_xor(P[si], 16), bb = __shfl_xor(P[si], 32), cc = __shfl_xor(P[si], 48);
                        tot[si] = P[si] + a + bb + cc; sufg[si] = (g == 0) ? (a + bb + cc) : (g == 1) ? (bb + cc) : (g == 2) ? a : 0.f; }
                    float hi = 0.f; f32x4 att[4];
#pragma unroll
                    for (int si = 3; si >= 0; --si) { float run = R + hi + sufg[si];
#pragma unroll
                        for (int r = 3; r >= 0; --r) { const int s = s0 + 16 * si + 4 * g + r; run += L[si][r]; att[si][r] = (s < t) ? __expf(z[si][r] - run) : 0.f; }
                        hi += tot[si]; }
                    R += hi;
#pragma unroll
                    for (int p = 0; p < 2; ++p) { v4u bw; bw.x = pk2(att[2 * p][0], att[2 * p][1]); bw.y = pk2(att[2 * p][2], att[2 * p][3]); bw.z = pk2(att[2 * p + 1][0], att[2 * p + 1][1]); bw.w = pk2(att[2 * p + 1][2], att[2 * p + 1][3]);
                        const bf16x8 bfrag = __builtin_bit_cast(bf16x8, bw);
#pragma unroll
                        for (int dt = 0; dt < 8; ++dt) { const v2u lo = *(const LAS v2u*)(sV + (16 * dt + l15) * AT_VS + (32 * p + 4 * g) * 2), hi2 = *(const LAS v2u*)(sV + (16 * dt + l15) * AT_VS + (32 * p + 16 + 4 * g) * 2);
                            v4u aw; aw.x = lo.x; aw.y = lo.y; aw.z = hi2.x; aw.w = hi2.y; OT[dt] = MFMA16(__builtin_bit_cast(bf16x8, aw), bfrag, OT[dt]); } }
                    wdone = __all(R > zb) != 0;
                }
                if (lane == 0) ((LAS unsigned*)(lds + AT_FLAGS))[8 * bf + w] = wdone ? 1u : 0u;
                if (it + 1 < nkb) AT_STORE(bf ^ 1);
                LDS_WAIT(); __syncthreads();
                const v4u f0 = *(const LAS v4u*)(lds + AT_FLAGS + 32 * bf), f1 = *(const LAS v4u*)(lds + AT_FLAGS + 32 * bf + 16);
                if ((f0.x & f0.y & f0.z & f0.w & f1.x & f1.y & f1.z & f1.w) != 0u) break;
            }
#undef AT_LOAD
#undef AT_STORE
            bf16* orow = O + (size_t)(tokb + t) * 2048 + h * 128 + 4 * g;
#pragma unroll
            for (int dt = 0; dt < 8; ++dt) { v2u ow; ow.x = pk2(OT[dt][0], OT[dt][1]); ow.y = pk2(OT[dt][2], OT[dt][3]); *(v2u*)(orow + 16 * dt) = ow; }
            LDS_WAIT(); __syncthreads();
        }
    }
}
#ifndef SKELETON
#define SKELETON 0
#endif
#ifndef REP_P0
#define REP_P0 1
#endif
#ifndef REP_NORM
#define REP_NORM 1
#endif
#ifndef REP_G1
#define REP_G1 1
#endif
#ifndef REP_GP
#define REP_GP 1
#endif
#ifndef REP_ML
#define REP_ML 1
#endif
#ifndef REP_AT
#define REP_AT 1
#endif
#ifndef REP_BAR
#define REP_BAR 1
#endif
#define OPQ_S(x) asm volatile("" : "+s"(x))
__global__ void __launch_bounds__(NWAVES * 64, 2) fwd_kernel(Ptrs Pdummy) {
    extern __shared__ __attribute__((aligned(16))) unsigned char lds_raw[];
    KArgs kp0 = (KArgs)__builtin_amdgcn_kernarg_segment_ptr();
    Frame F;
    F.lds = (LAS unsigned char*)lds_raw;
    if (threadIdx.x < 4) ((LAS unsigned*)(F.lds + LDSCTL_OFF))[threadIdx.x] = 0u;
    __syncthreads();
    XcdBarrier bar = xcd_barrier_post((unsigned*)(kp0->ws + WS_CTL) + CW_BAR, (volatile LAS unsigned*)(F.lds + LDSCTL_OFF));
#define GRID_BAR() do { for (int rb_ = 0; rb_ < REP_BAR; ++rb_) xcd_barrier(bar); } while (0)

    jobs_init(F, kp0);
    for (int rep = 0; rep < REP_P0; ++rep) p0_convert(F, kp0);
    GRID_BAR();

    for (int st = 0; st < 13; ++st) {
#define DECODE(kp_) KArgs kp_ = kp0; OPQ_S(kp_); int st_ = st; OPQ_S(st_); \
        const int sb = (st_ < 6) ? st_ : st_ - 1, l = sb / 3, ty = sb - 3 * l; (void)ty; \
        const bool is_kv = (st_ == 6), is_ffn = !is_kv && (ty != 1), is_ml = !is_kv && (ty == 1) && (l < 2), is_at = !is_kv && (ty == 1) && (l >= 2); (void)is_ffn; (void)is_ml; (void)is_at; \
        unsigned char* ws = kp_->ws; unsigned char* scr = ws + WS_SCR; (void)scr; \
        float* X = (float*)(ws + WS_X); bf16* XN = (bf16*)(ws + WS_XN); (void)X; (void)XN; \
        const float* xcur = (st_ == 0) ? kp_->in[0] : X; (void)xcur;
        int kind;
        { DECODE(kp)
          kind = is_kv ? 3 : is_ffn ? 0 : is_ml ? 1 : 2;
          const float* gain = is_kv ? kp->in[12] : ((ty == 0 ? kp->in[1] : ty == 1 ? kp->in[4] : kp->in[5]) + (size_t)l * D);
          if (st_ == 7) knorm_phase(F, (const bf16*)(ws + WS_KB), (float*)(ws + WS_KPART));
          for (int rep = 0; rep < REP_NORM; ++rep) norm_phase(F, xcur, gain, XN, is_ml, (const float*)(ws + WS_WG) + (size_t)(l & 1) * D * 16, kp->in[9] + (l & 1) * 16, (float*)(ws + WS_GATES)); }
        GRID_BAR();
        if (kind == 0) {
#if !SKELETON && !defined(NO_G1)
            { DECODE(kp)
              const int f = 2 * l + (ty == 2 ? 1 : 0);
              pg8::Gemm gm{XN, (const bf16*)(ws + WS_FFN + (size_t)f * FFN_BYTES), M, 2 * DFF, D}; pg8::StaticOrder S; S.init(M, 2 * DFF, (int)gridDim.x, (int)blockIdx.x); pg8::EpiSwiGLU E{(bf16*)(scr + SCR_ACT), DFF};
              for (int rep = 0; rep < REP_G1; ++rep) pg8::gemm_phase<pg8::EpiSwiGLU, pg8::StaticOrder, true, true>(F.lds, gm, S, E); }
            if (blockIdx.x >= 128) convert_slot(F, st);
#endif
            GRID_BAR();
        } else {
#if !SKELETON && !defined(NO_GP)
            for (int ci = 0; ci < (kind == 2 ? 1 : 2); ++ci) {
                DECODE(kp)
                const unsigned char* awl = ws + WS_AW + (size_t)(l & 1) * 32 * MiB;
                const bf16 *a, *b; bf16* o; int Mx, Nx, ld, sc0; float scv = 0.08838834764831845f;
                if (ci == 0) { a = XN; Mx = M;
                    if (is_ml)      { b = (const bf16*)awl; Nx = 4096; o = (bf16*)(scr + SCR_PROJ); ld = 4096; sc0 = 1024; }
                    else if (is_at) { b = (const bf16*)(ws + WS_BQ + (size_t)(l - 2) * 8 * MiB); Nx = 2048; o = (bf16*)(scr + SCR_Q); ld = 2048; sc0 = 2048; }
                    else            { b = (const bf16*)(ws + WS_KVK); Nx = 2048; o = (bf16*)(ws + WS_KB); ld = 2048; sc0 = 0; } }
                else { b = XN; Mx = 2048; Nx = M; ld = M; sc0 = 0;
                    if (is_ml) { a = (const bf16*)(awl + 16 * MiB); o = (bf16*)(scr + SCR_VTA); }
                    else       { a = (const bf16*)(ws + WS_KVV); o = (bf16*)(ws + WS_VTB); } }
                pg8::Gemm gm{a, b, Mx, Nx, D}; pg8::StaticOrder S; S.init(Mx, Nx, (int)gridDim.x, (int)blockIdx.x);
                pg8::EpiBf16 E{o, ld, sc0, scv};
                for (int rep = 0; rep < REP_GP; ++rep) pg8::gemm_phase<pg8::EpiBf16, pg8::StaticOrder, true, true>(F.lds, gm, S, E);
            }
#endif
            GRID_BAR();
            if (kind == 3) continue;
            if (kind == 1) {
#if !SKELETON && !defined(NO_ML)
                { DECODE(kp)
                  for (int rep = 0; rep < REP_ML; ++rep) mlstm_phase(F, (const bf16*)(scr + SCR_PROJ), (const bf16*)(scr + SCR_VTA), (const float*)(ws + WS_GATES), (float*)(scr + SCR_HSNUM), (float*)(ws + WS_DN), st); }
#endif
                GRID_BAR();
#if !SKELETON
                { DECODE(kp)
                  mlstm_finalize_phase(F, (const float*)(scr + SCR_HSNUM), (const float*)(ws + WS_DN), (const bf16*)(scr + SCR_PROJ), kp->in[10] + (size_t)l * 2048, (bf16*)(scr + SCR_HS)); }
#endif
                GRID_BAR();
            } else {
#if !SKELETON && !defined(NO_AT)
                { DECODE(kp)
                  for (int rep = 0; rep < REP_AT; ++rep) attn_phase(F, (const bf16*)(scr + SCR_Q), (const bf16*)(ws + WS_KB), (const bf16*)(ws + WS_VTB), (bf16*)(scr + SCR_O), (const float*)(ws + WS_KPART)); }
#endif
                GRID_BAR();
            }
        }
        { DECODE(kp)
#if !SKELETON && !defined(NO_GR)
          const unsigned char* awl = ws + WS_AW + (size_t)(l & 1) * 32 * MiB;
          const int f = 2 * l + (ty == 2 ? 1 : 0);
          const bf16* rA = is_ffn ? (const bf16*)(scr + SCR_ACT) : is_ml ? (const bf16*)(scr + SCR_HS) : (const bf16*)(scr + SCR_O);
          const bf16* rB = is_ffn ? (const bf16*)(ws + WS_FFN + (size_t)f * FFN_BYTES + W1_BYTES) : is_ml ? (const bf16*)(awl + 24 * MiB) : (const bf16*)(ws + WS_BO + (size_t)(l - 2) * 8 * MiB);
          pg8::Gemm gm{rA, rB, M, D, is_ffn ? DFF : D}; pg8::StaticOrder S; S.init(M, D, (int)gridDim.x, (int)blockIdx.x); pg8::EpiRes E{xcur, X, D, is_ffn ? 0.5f : 1.0f};
          pg8::gemm_phase<pg8::EpiRes, pg8::StaticOrder, true, true>(F.lds, gm, S, E);
#else
          PHASE_IDS
          const int gw = vcu * NWAVES + wave, NGW = G * NWAVES;
          for (int m = gw; m < M; m += NGW) { const f32x4* xr = (const f32x4*)(xcur + (size_t)m * D) + lane; f32x4* xo = (f32x4*)(X + (size_t)m * D) + lane;
              for (int j = 0; j < 8; ++j) xo[64 * j] = xr[64 * j]; }
#endif
        }
        GRID_BAR();
    }
    { KArgs kp = kp0; OPQ_S(kp); final_norm_phase(F, (const float*)(kp->ws + WS_X), kp->in[16], kp->out); }
}

extern "C" void kernel_launch(void* const* d_in, const int* in_sizes, int n_in, void* d_out, int out_size, void* d_ws, size_t ws_size, hipStream_t stream) {
    static int grid = 0;
    if (grid == 0) {
        if (n_in != 17 || in_sizes[0] != M * D || out_size != M * D || ws_size < WS_END) {
            fprintf(stderr, "kernel_launch: built for 17 inputs, x/out of %d floats, >= %zu bytes of workspace; got n_in %d, in0 %d, out %d, ws %zu; nothing launched\n", M * D, (size_t)WS_END, n_in, n_in > 0 ? in_sizes[0] : -1, out_size, ws_size);
            grid = -1; return; }
        int dev = 0, cus = 0, per_cu = 0;
        if (hipGetDevice(&dev) != hipSuccess || hipDeviceGetAttribute(&cus, hipDeviceAttributeMultiprocessorCount, dev) != hipSuccess) { fprintf(stderr, "kernel_launch: device query failed\n"); grid = -1; return; }
        if (hipFuncSetAttribute((const void*)fwd_kernel, hipFuncAttributeMaxDynamicSharedMemorySize, LDS_BYTES) != hipSuccess) { fprintf(stderr, "kernel_launch: hipFuncSetAttribute failed\n"); grid = -1; return; }
        if (hipOccupancyMaxActiveBlocksPerMultiprocessor(&per_cu, (const void*)fwd_kernel, NWAVES * 64, LDS_BYTES) != hipSuccess || per_cu < 1)
            fprintf(stderr, "kernel_launch: note: occupancy query reports %d workgroups per CU\n", per_cu);
        (void)hipGetLastError();
        grid = cus;
    }
    if (grid < 0) return;
    if (hipMemsetAsync((char*)d_ws + WS_CTL, 0, CTL_BYTES, stream) != hipSuccess) { fprintf(stderr, "kernel_launch: memset failed\n"); return; }
    Ptrs p{};
    for (int i = 0; i < 17; ++i) p.in[i] = (const float*)d_in[i];
    p.out = (float*)d_out; p.ws = (unsigned char*)d_ws;
    hipLaunchKernelGGL(fwd_kernel, dim3(grid), dim3(NWAVES * 64), LDS_BYTES, stream, p);
    const hipError_t le = hipPeekAtLastError();
    if (le != hipSuccess) fprintf(stderr, "kernel_launch: launch failed: %s (grid %d)\n", hipGetErrorName(le), grid);
}
```
